# Optimizing an MI355X kernel written in HIP

```python
import math
import jax, jax.numpy as jnp
from jax import lax
import numpy as np

D_MODEL = 1024
BATCH = 8
SEQ = 4096
DEPTH = 4

DA_HEADS = 4
DA_QK_DIM = 64
DA_V_DIM = 2 * DA_QK_DIM
SB_HEADS = 8
SB_DIM = 64
DIL_PAIRS = ((128, 1), (512, 4), (2048, 16))
DIL_GROUPS = len(DIL_PAIRS)
DIL_HEADS_PER_GROUP = 4
DIL_HEADS = DIL_GROUPS * DIL_HEADS_PER_GROUP
DIL_DIM = 128

N_BRANCHES = 3
Q_BLOCK = 128
D_FF = 4 * D_MODEL
PLE_DIM = 256
REL_BUCKETS = 32
REL_MAX_DIST = 2048
BIAS_HEADS = DA_HEADS + DIL_HEADS
DEEPNORM_ALPHA = (2 * DEPTH) ** 0.25
DEEPNORM_BETA = (8 * DEPTH) ** -0.25
LN_EPS = 1e-5
RMS_EPS = 1e-5

IN_SIZES = (
    DA_HEADS * 2 * DA_QK_DIM, DA_HEADS * 2 * DA_QK_DIM, DA_HEADS * DA_V_DIM,
    SB_HEADS * SB_DIM, SB_HEADS * SB_DIM, SB_HEADS * SB_DIM,
    DIL_HEADS * DIL_DIM, DIL_HEADS * DIL_DIM, DIL_HEADS * DIL_DIM,
    N_BRANCHES * D_MODEL,
)
VALUE_SLOTS = (2, 5, 8)
IN_COLS = sum(IN_SIZES)
DA_OUT = DA_HEADS * DA_V_DIM
SB_OUT = SB_HEADS * SB_DIM
DIL_OUT = DIL_HEADS_PER_GROUP * DIL_DIM

kernel_name = "hybrid_gated_diff_stickbreak_dilated"


def _split_points():
    return [int(c) for c in np.cumsum(IN_SIZES)[:-1]]


def layer_norm(x, g, b):
    xf = x.astype(jnp.float32)
    mu = xf.mean(-1, keepdims=True)
    var = jnp.square(xf - mu).mean(-1, keepdims=True)
    return ((xf - mu) * lax.rsqrt(var + LN_EPS) * g + b).astype(x.dtype)


def rel_bucket(dist):
    max_exact = REL_BUCKETS // 2
    d = jnp.maximum(dist, 0)
    log_ratio = jnp.log(jnp.maximum(d, 1).astype(jnp.float32) / max_exact) / math.log(REL_MAX_DIST / max_exact)
    large = max_exact + (log_ratio * (REL_BUCKETS - max_exact)).astype(jnp.int32)
    return jnp.where(d < max_exact, d, jnp.minimum(large, REL_BUCKETS - 1))


def diff_attention(q, k, v, lam, norm_g, bias_table, lam_init):
    B, S, H, _, d = q.shape
    nblk = S // Q_BLOCK
    scale = d ** -0.5
    q = q.transpose(0, 2, 3, 1, 4)
    k = k.transpose(0, 2, 3, 1, 4)
    vt = v.transpose(0, 2, 1, 3)
    qb = q.reshape(B, H, 2, nblk, Q_BLOCK, d).transpose(3, 0, 1, 2, 4, 5)
    k_pos = jnp.arange(S)

    def block(args):
        qi, i = args
        q_pos = i * Q_BLOCK + jnp.arange(Q_BLOCK)
        rel = q_pos[:, None] - k_pos[None, :]
        bias = bias_table[rel_bucket(rel)].transpose(2, 0, 1).astype(jnp.float32)
        logits = jnp.einsum('bhmqd,bhmkd->bhmqk', qi, k).astype(jnp.float32) * scale
        logits = jnp.where(rel >= 0, logits + bias[None, :, None], -jnp.inf)
        prob = jax.nn.softmax(logits, axis=-1)
        w = prob[:, :, 0] - lam * prob[:, :, 1]
        return jnp.einsum('bhqk,bhkd->bhqd', w.astype(vt.dtype), vt)

    o = lax.map(block, (qb, jnp.arange(nblk)))
    o = o.transpose(1, 0, 3, 2, 4).reshape(B, S, H, -1).astype(jnp.float32)
    o = o * lax.rsqrt(jnp.mean(jnp.square(o), axis=-1, keepdims=True) + RMS_EPS) * norm_g
    o = o * (1.0 - lam_init)
    return o.reshape(B, S, -1).astype(v.dtype)


def stick_breaking_attention(q, k, v):
    B, S, H, d = q.shape
    nblk = S // Q_BLOCK
    scale = d ** -0.5
    qb = q.reshape(B, nblk, Q_BLOCK, H, d).transpose(1, 0, 3, 2, 4)
    kt = k.transpose(0, 2, 1, 3)
    vt = v.transpose(0, 2, 1, 3)
    k_pos = jnp.arange(S)

    def block(args):
        qi, i = args
        q_pos = i * Q_BLOCK + jnp.arange(Q_BLOCK)
        before = k_pos[None, :] < q_pos[:, None]
        z = jnp.einsum('bhqd,bhkd->bhqk', qi, kt).astype(jnp.float32) * scale
        log_keep = jnp.where(before, jax.nn.log_sigmoid(-z), 0.0)
        later = lax.cumsum(log_keep, axis=3, reverse=True) - log_keep
        a = jnp.where(before, jnp.exp(jax.nn.log_sigmoid(z) + later), 0.0)
        return jnp.einsum('bhqk,bhkd->bhqd', a.astype(vt.dtype), vt)

    o = lax.map(block, (qb, jnp.arange(nblk)))
    return o.transpose(1, 0, 3, 2, 4).reshape(B, S, H * d)


def dilated_group(q, k, v, bias_table, window, dilation):
    B, S, H, dh = q.shape
    n = window // dilation
    L = -(-S // dilation)
    Lp = -(-L // n) * n
    nb = Lp // n

    def to_strided(a):
        a = jnp.pad(a, ((0, 0), (0, Lp * dilation - S), (0, 0), (0, 0)))
        a = a.reshape(B, Lp, dilation, H, dh).transpose(0, 2, 3, 1, 4)
        return a.reshape(B, dilation, H, nb, n, dh)

    def with_prev(a):
        prev = jnp.pad(a, ((0, 0), (0, 0), (0, 0), (1, 0), (0, 0), (0, 0)))[:, :, :, :-1]
        return jnp.concatenate([prev, a], axis=4)

    qs = to_strided(q)
    kb = with_prev(to_strided(k))
    vb = with_prev(to_strided(v))
    steps = jnp.arange(n)[:, None] + n - jnp.arange(2 * n)[None, :]
    valid_local = (steps >= 0) & (steps <= n)
    no_prev = (jnp.arange(nb)[:, None, None] == 0) & (jnp.arange(2 * n)[None, None, :] < n)
    valid = valid_local[None] & ~no_prev
    bias = bias_table[rel_bucket(steps * dilation)].transpose(2, 0, 1).astype(jnp.float32)
    logits = jnp.einsum('brhcqd,brhckd->brhcqk', qs, kb).astype(jnp.float32) * dh ** -0.5
    logits = jnp.where(valid, logits + bias[None, None, :, None], -jnp.inf)
    lse = jax.nn.logsumexp(logits, axis=-1)
    prob = jnp.exp(logits - lse[..., None])
    o = jnp.einsum('brhcqk,brhckd->brhcqd', prob.astype(vb.dtype), vb)
    o = o.reshape(B, dilation, H, Lp, dh).transpose(0, 3, 1, 2, 4).reshape(B, Lp * dilation, H, dh)[:, :S]
    lse = lse.reshape(B, dilation, H, Lp).transpose(0, 3, 1, 2).reshape(B, Lp * dilation, H)[:, :S]
    return o, lse


def dilated_attention(q, k, v, bias_table):
    B, S = q.shape[:2]
    outs, lses = [], []
    for g, (window, dilation) in enumerate(DIL_PAIRS):
        cols = bias_table[:, g * DIL_HEADS_PER_GROUP:(g + 1) * DIL_HEADS_PER_GROUP]
        o, lse = dilated_group(q[:, :, g], k[:, :, g], v[:, :, g], cols, window, dilation)
        outs.append(o)
        lses.append(lse)
    wts = jax.nn.softmax(jnp.stack(lses, axis=0), axis=0)
    o = wts[0][..., None] * outs[0] + wts[1][..., None] * outs[1] + wts[2][..., None] * outs[2]
    return o.reshape(B, S, -1).astype(q.dtype)


def mixer(x, w_in, da_lambda, da_norm, w_branch_da, w_branch_sb, w_branch_dil, w_out, rel_bias, lam_init):
    B, S, D = x.shape
    proj = x @ w_in
    (da_q, da_k, da_v, sb_q, sb_k, sb_v, dl_q, dl_k, dl_v, gates) = jnp.split(proj, _split_points(), axis=-1)
    lam_f = da_lambda.astype(jnp.float32)
    lam = jnp.exp(jnp.sum(lam_f[0] * lam_f[1])) - jnp.exp(jnp.sum(lam_f[2] * lam_f[3])) + lam_init
    o_da = diff_attention(da_q.reshape(B, S, DA_HEADS, 2, DA_QK_DIM),
                          da_k.reshape(B, S, DA_HEADS, 2, DA_QK_DIM),
                          da_v.reshape(B, S, DA_HEADS, DA_V_DIM),
                          lam, da_norm, rel_bias[:, :DA_HEADS], lam_init)
    o_sb = stick_breaking_attention(sb_q.reshape(B, S, SB_HEADS, SB_DIM),
                                    sb_k.reshape(B, S, SB_HEADS, SB_DIM),
                                    sb_v.reshape(B, S, SB_HEADS, SB_DIM))
    dil_shape = (B, S, DIL_GROUPS, DIL_HEADS_PER_GROUP, DIL_DIM)
    o_dl = dilated_attention(dl_q.reshape(dil_shape), dl_k.reshape(dil_shape), dl_v.reshape(dil_shape),
                             rel_bias[:, DA_HEADS:])
    g = jax.nn.sigmoid(gates).reshape(B, S, N_BRANCHES, D)
    merged = (g[:, :, 0] * (o_da @ w_branch_da) + g[:, :, 1] * (o_sb @ w_branch_sb)
              + g[:, :, 2] * (o_dl @ w_branch_dil))
    return merged @ w_out


def setup_inputs(seed: int = 0) -> dict:
    key = jax.random.key(seed)
    ks = jax.random.split(key, 20)
    f32 = jnp.float32
    nrm = lambda k, shape, s: jax.random.normal(k, shape, f32) * s
    col_scale = jnp.concatenate([jnp.full((s,), DEEPNORM_BETA if idx in VALUE_SLOTS else 1.0, f32)
                                 for idx, s in enumerate(IN_SIZES)])
    return {
        "x": nrm(ks[0], (BATCH, SEQ, D_MODEL), 1.0),
        "p": nrm(ks[1], (DEPTH, BATCH, SEQ, PLE_DIM), 1.0),
        "w_in": nrm(ks[2], (DEPTH, D_MODEL, IN_COLS), D_MODEL ** -0.5) * col_scale,
        "da_lambda": nrm(ks[3], (DEPTH, 4, DA_QK_DIM), 0.1),
        "da_norm": 1.0 + nrm(ks[4], (DEPTH, DA_V_DIM), 0.02),
        "w_branch_da": nrm(ks[5], (DEPTH, DA_OUT, D_MODEL), DA_OUT ** -0.5),
        "w_branch_sb": nrm(ks[6], (DEPTH, SB_OUT, D_MODEL), SB_OUT ** -0.5),
        "w_branch_dil": nrm(ks[7], (DEPTH, DIL_OUT, D_MODEL), DIL_OUT ** -0.5),
        "w_out": nrm(ks[8], (DEPTH, D_MODEL, D_MODEL), D_MODEL ** -0.5 * DEEPNORM_BETA),
        "ln1_g": 1.0 + nrm(ks[9], (DEPTH, D_MODEL), 0.02),
        "ln1_b": nrm(ks[10], (DEPTH, D_MODEL), 0.02),
        "w_up": nrm(ks[11], (DEPTH, D_MODEL, D_FF), D_MODEL ** -0.5),
        "w_down": nrm(ks[12], (DEPTH, D_FF, D_MODEL), D_FF ** -0.5 * DEEPNORM_BETA),
        "w_ple_gate": nrm(ks[13], (DEPTH, D_MODEL, D_MODEL), D_MODEL ** -0.5),
        "w_ple": nrm(ks[14], (DEPTH, PLE_DIM, D_MODEL), PLE_DIM ** -0.5 * DEEPNORM_BETA),
        "ln2_g": 1.0 + nrm(ks[15], (DEPTH, D_MODEL), 0.02),
        "ln2_b": nrm(ks[16], (DEPTH, D_MODEL), 0.02),
        "rel_bias": nrm(ks[17], (REL_BUCKETS, BIAS_HEADS), 0.3),
    }


def reference(x, p, w_in, da_lambda, da_norm, w_branch_da, w_branch_sb, w_branch_dil, w_out,
              ln1_g, ln1_b, w_up, w_down, w_ple_gate, w_ple, ln2_g, ln2_b, rel_bias):
    for i in range(DEPTH):
        lam_init = 0.8 - 0.6 * math.exp(-0.3 * i)
        m = mixer(x, w_in[i], da_lambda[i], da_norm[i], w_branch_da[i], w_branch_sb[i],
                  w_branch_dil[i], w_out[i], rel_bias, lam_init)
        x = layer_norm(DEEPNORM_ALPHA * x + m, ln1_g[i], ln1_b[i])
        hid = jax.nn.relu(x @ w_up[i])
        c = jnp.square(hid) @ w_down[i]
        ple = jax.nn.sigmoid(x @ w_ple_gate[i]) * (p[i] @ w_ple[i])
        x = layer_norm(DEEPNORM_ALPHA * x + c + ple, ln2_g[i], ln2_b[i])
    return x
```

```cpp
#include <hip/hip_runtime.h>
#include <hip/hip_cooperative_groups.h>
#include <cstdio>
#include <cstdint>
#include <cmath>
namespace cg = cooperative_groups;
namespace pg8 {
#define PG8_LAS __attribute__((address_space(3)))
typedef unsigned short bf16_t;
typedef short bf16x8 __attribute__((ext_vector_type(8)));
typedef float f32x4 __attribute__((ext_vector_type(4)));
typedef unsigned u32x4 __attribute__((ext_vector_type(4)));
constexpr int BM = 256, BK = 64, HALF = 128, HTB = HALF * BK * 2  , STAGE_BYTES = 8 * HTB, NXCD = 8, WGM = 8;

__host__ __device__ __forceinline__ int lds_byte(int r, int c) { const int st = (r >> 4) * 2 + (c >> 5), rr = r & 15, cc = c & 31, ob = rr * 64 + cc * 2; return st * 1024 + (ob ^ (((ob >> 9) & 1) << 5)); }
__host__ __device__ __forceinline__ void stage_rc(int b, int& R, int& C) { const int st = b / 1024, sb = b % 1024, swz = sb ^ (((sb >> 9) & 1) << 5); R = (st >> 1) * 16 + swz / 64; C = (st & 1) * 32 + (swz % 64) / 2; }
__host__ __device__ __forceinline__ int perm32(int rho) { const int n = rho >> 4, i = rho & 15; return 8 * (i >> 2) + 4 * n + (i & 3); }

struct Unit { int pm, pn; };
struct Gemm { const bf16_t* A; const bf16_t* Bt; int M, N, K; };

struct StaticOrder {
    int nM, nN, nwg, G, c;
    __host__ __device__ void init(int M, int N, int G_, int c_) { nM = M / BM; nN = N / BM; nwg = nM * nN; G = G_; c = c_; }
    __host__ __device__ bool next(int i, Unit& u) const {
        const long L = (long)i * G + c; if (L >= nwg) return false;
        int wgid = (int)L; { const int q = nwg / NXCD, r = nwg % NXCD, xcd = wgid % NXCD, off = wgid / NXCD; wgid = (xcd < r ? xcd * (q + 1) : r * (q + 1) + (xcd - r) * q) + off; }
        const int nig = WGM * nN, gid = wgid / nig, fm = gid * WGM, gsz = (nM - fm) < WGM ? (nM - fm) : WGM;
        u.pm = fm + ((wgid % nig) % gsz); u.pn = (wgid % nig) / gsz; return true;
    }
    __device__ __forceinline__ void a_ready(const Unit&) const {}
    __device__ __forceinline__ void done(const Unit&) const {}
};

__device__ __forceinline__ unsigned cvt_pk_bf16(float lo, float hi) { unsigned r; asm volatile("v_cvt_pk_bf16_f32 %0, %1, %2" : "=v"(r) : "v"(lo), "v"(hi)); return r; }
typedef float f32x2 __attribute__((ext_vector_type(2)));
typedef unsigned u32x2 __attribute__((ext_vector_type(2)));
__device__ __forceinline__ float fsigmoid(float x) { return __builtin_amdgcn_rcpf(1.0f + __expf(-x)); }

struct EpiB {
    static constexpr bool PERM = true, AFTER_DRAIN = false;
    int mode; bf16_t* QK; bf16_t* VT; bf16_t* GT; bf16_t* HID; int Mc;
    __device__ __forceinline__ void operator()(const f32x4 (&acc)[2][2][4][2], const Unit& u, int wr, int wc, int fr, int fq) const {
        const int row0 = u.pm * BM + wr * 64 + fr; const int cl = wc * 32 + 8 * fq; const int pn = u.pn;
        int kind, dt;
        if (mode == 1) { kind = 3; dt = pn; }
        else if (pn < 12) { const int s = pn >> 1, o = pn & 1;
            if (s == 2) { kind = 1; dt = o; } else if (s == 5) { kind = 1; dt = 2 + o; } else { kind = 0; dt = (s < 2 ? s * 2 : (s - 1) * 2) + o; } }
        else if (pn < 24) { kind = 0; dt = 8 + (pn - 12); }
        else if (pn < 30) { kind = 1; dt = 4 + (pn - 24); }
        else { kind = 2; dt = pn - 30; }
        if (kind == 1) {
            const int ld = dt < 6 ? 0 : (dt < 8 ? 2 : 4);
#pragma unroll
            for (int ai = 0; ai < 2; ++ai)
#pragma unroll
                for (int m = 0; m < 4; ++m) {
                    const int t = row0 + ai * HALF + m * 16; const int s = t & 4095;
                    const int pt = (t & ~4095) + (s & ((1 << ld) - 1)) * (4096 >> ld) + (s >> ld);
#pragma unroll
                    for (int bj = 0; bj < 2; ++bj)
#pragma unroll
                        for (int n = 0; n < 2; ++n) { const f32x4 v = acc[ai][bj][m][n];
                            bf16_t* p = VT + (size_t)(dt * 256 + bj * HALF + cl + 4 * n) * Mc + pt;
                            const unsigned w0 = cvt_pk_bf16(v[0], v[1]), w1 = cvt_pk_bf16(v[2], v[3]);
                            p[0] = (bf16_t)(w0 & 0xffffu); p[(size_t)Mc] = (bf16_t)(w0 >> 16); p[2 * (size_t)Mc] = (bf16_t)(w1 & 0xffffu); p[3 * (size_t)Mc] = (bf16_t)(w1 >> 16); }
                }
            return;
        }
        bf16_t* base; int ldc;
        if (kind == 0) { base = QK; ldc = 5120; } else if (kind == 2) { base = GT; ldc = 3072; } else { base = HID; ldc = 4096; }
        base += dt * 256 + cl;
#pragma unroll
        for (int ai = 0; ai < 2; ++ai)
#pragma unroll
            for (int m = 0; m < 4; ++m) { bf16_t* rowp = base + (size_t)(row0 + ai * HALF + m * 16) * ldc;
#pragma unroll
                for (int bj = 0; bj < 2; ++bj) { f32x4 v0 = acc[ai][bj][m][0], v1 = acc[ai][bj][m][1];
                    if (kind == 2) {
#pragma unroll
                        for (int e = 0; e < 4; ++e) { v0[e] = fsigmoid(v0[e]); v1[e] = fsigmoid(v1[e]); } }
                    else if (kind == 3) {
#pragma unroll
                        for (int e = 0; e < 4; ++e) { const float a = fmaxf(v0[e], 0.f), b = fmaxf(v1[e], 0.f); v0[e] = a * a; v1[e] = b * b; } }
                    u32x4 w; w.x = cvt_pk_bf16(v0[0], v0[1]); w.y = cvt_pk_bf16(v0[2], v0[3]); w.z = cvt_pk_bf16(v1[0], v1[1]); w.w = cvt_pk_bf16(v1[2], v1[3]);
                    *(u32x4*)(rowp + bj * HALF) = w; } }
    }
};

struct EpiF {
    static constexpr bool PERM = false, AFTER_DRAIN = false;
    int mode; float* F; const float* X; float* Y; const bf16_t* GT; bf16_t* OB; int gofs; int rowoff; float alpha;
    __device__ __forceinline__ void operator()(const f32x4 (&acc)[2][2][4][2], const Unit& u, int wr, int wc, int fr, int fq) const {
        const int row0 = u.pm * BM + wr * 64 + fr; const int col0 = u.pn * BM + wc * 32 + 4 * fq;
#pragma unroll
        for (int ai = 0; ai < 2; ++ai)
#pragma unroll
            for (int m = 0; m < 4; ++m) { const int row = row0 + ai * HALF + m * 16;
#pragma unroll
                for (int bj = 0; bj < 2; ++bj)
#pragma unroll
                    for (int n = 0; n < 2; ++n) { const int col = col0 + bj * HALF + n * 16; const f32x4 v = acc[ai][bj][m][n];
                        const size_t o = (size_t)row * 1024 + col;
                        if (mode <= 2) {
                            const u32x2 gw = *(const u32x2*)(GT + (size_t)row * 3072 + gofs + col);
                            f32x4 g; g[0] = __uint_as_float(gw.x << 16); g[1] = __uint_as_float(gw.x & 0xffff0000u); g[2] = __uint_as_float(gw.y << 16); g[3] = __uint_as_float(gw.y & 0xffff0000u);
                            f32x4 r = g * v;
                            if (mode >= 1) r += *(const f32x4*)(F + o);
                            if (mode <= 1) *(f32x4*)(F + o) = r;
                            else { u32x2 w; w.x = cvt_pk_bf16(r[0], r[1]); w.y = cvt_pk_bf16(r[2], r[3]); *(u32x2*)(OB + o) = w; }
                        } else if (mode == 3) {
                            const size_t og = o + (size_t)rowoff * 1024;
                            *(f32x4*)(Y + og) = *(const f32x4*)(X + og) * alpha + v;
                        } else if (mode == 4) {
                            f32x4 r; r[0] = fsigmoid(v[0]); r[1] = fsigmoid(v[1]); r[2] = fsigmoid(v[2]); r[3] = fsigmoid(v[3]);
                            *(f32x4*)(F + o) = r;
                        } else if (mode == 5) {
                            *(f32x4*)(Y + o) = *(const f32x4*)(Y + o) * alpha + *(const f32x4*)(F + o) * v;
                        } else {
                            *(f32x4*)(Y + o) = *(const f32x4*)(Y + o) + v;
                        }
                    }
                asm volatile("" ::: "memory"); }
    }
};
template <class Epi, class Sched, bool ALIGN_EPI = false, bool SP2 = false>
__device__ __forceinline__ void gemm_phase(PG8_LAS unsigned char* lds, const Gemm g, const Sched& S, const Epi& E, const int tid_in) {
    const int tid = tid_in, wid = __builtin_amdgcn_readfirstlane(tid >> 6), lane = tid & 63, wr = wid >> 2, wc = wid & 3, fr = lane & 15, fq = lane >> 4;
    const int K = g.K, nt = K / BK;
    unsigned voffA[2], voffB[2];
#pragma unroll
    for (int i = 0; i < 2; ++i) { int R, C; stage_rc(tid * 16 + i * 8192, R, C); const int Rb = Epi::PERM ? ((R & ~31) + perm32(R & 31)) : R;
        voffA[i] = (unsigned)(R * K + C) * 2u; voffB[i] = (unsigned)(Rb * K + C) * 2u; }
    const size_t kstep = (size_t)(BK * 2);
    const size_t hstep = (size_t)HALF * K * 2;
    const size_t tstep = 2 * hstep;
    const unsigned ldsw = (unsigned)wid * 1024u;
    const int aoff = lds_byte(wr * 64 + fr, fq * 8), boff = lds_byte(wc * 32 + fr, fq * 8);
#define PG8_SA(b, h) (((b) * 2 + (h)) * HTB)
#define PG8_SB(b, h) ((4 + (b) * 2 + (h)) * HTB)
#define PG8_STAGE(bufoff, gbase, voff) do { _Pragma("unroll") for (int _i = 0; _i < 2; ++_i) \
        __builtin_amdgcn_global_load_lds((const unsigned*)((const char*)(gbase) + (voff)[_i]), (PG8_LAS unsigned*)(lds + (bufoff) + ldsw + _i * 8192), 16, 0, 0); } while (0)
#define PG8_LDA(dst, b, h) do { _Pragma("unroll") for (int m = 0; m < 4; ++m) _Pragma("unroll") for (int k = 0; k < 2; ++k) dst[m][k] = *(const PG8_LAS bf16x8*)(lds + PG8_SA(b, h) + aoff + m * 2048 + k * 1024); } while (0)
#define PG8_LDB(dst, b, h) do { _Pragma("unroll") for (int n = 0; n < 2; ++n) _Pragma("unroll") for (int k = 0; k < 2; ++k) dst[n][k] = *(const PG8_LAS bf16x8*)(lds + PG8_SB(b, h) + boff + n * 2048 + k * 1024); } while (0)
#define PG8_MMA(ai, bj, At, Bt) do { __builtin_amdgcn_s_setprio(1); _Pragma("unroll") for (int m = 0; m < 4; ++m) _Pragma("unroll") for (int n = 0; n < 2; ++n) _Pragma("unroll") for (int k = 0; k < 2; ++k) \
        acc[ai][bj][m][n] = __builtin_amdgcn_mfma_f32_16x16x32_bf16(Bt[n][k], At[m][k], acc[ai][bj][m][n], 0, 0, 0); __builtin_amdgcn_s_setprio(0); } while (0)
#define PG8_WAIT_V(n) asm volatile("s_waitcnt vmcnt(" #n ")" ::: "memory")
#define PG8_WAIT_L(n) asm volatile("s_waitcnt lgkmcnt(" #n ")" ::: "memory")
#define PG8_BAR __builtin_amdgcn_s_barrier()
#define PG8_SCHED __builtin_amdgcn_sched_barrier(0)
    Unit cur, nxt; int ui = 0;
    if (!S.next(0, cur)) return;
    f32x4 acc[2][2][4][2];
#pragma unroll
    for (int a = 0; a < 2; ++a)
#pragma unroll
        for (int b = 0; b < 2; ++b)
#pragma unroll
            for (int m = 0; m < 4; ++m)
#pragma unroll
                for (int n = 0; n < 2; ++n) acc[a][b][m][n] = (f32x4){0.f, 0.f, 0.f, 0.f};
    bf16x8 At[4][2], B0[2][2], B1[2][2];
    const char* cA = (const char*)g.A + (size_t)cur.pm * tstep; const char* cB = (const char*)g.Bt + (size_t)cur.pn * tstep;
    S.a_ready(cur);
    if constexpr (SP2) {
        PG8_STAGE(PG8_SB(0, 0), cB, voffB); PG8_STAGE(PG8_SB(0, 1), cB + hstep, voffB); PG8_STAGE(PG8_SA(0, 0), cA, voffA); PG8_STAGE(PG8_SA(0, 1), cA + hstep, voffA);
        if (wr == 1) PG8_BAR;
        PG8_WAIT_V(2); PG8_BAR;
        PG8_STAGE(PG8_SB(1, 0), cB + kstep, voffB); PG8_STAGE(PG8_SA(1, 0), cA + kstep, voffA); PG8_STAGE(PG8_SB(1, 1), cB + hstep + kstep, voffB);
        PG8_WAIT_V(6); PG8_BAR;
    } else {
        PG8_STAGE(PG8_SB(0, 0), cB, voffB); PG8_STAGE(PG8_SA(0, 0), cA, voffA); PG8_STAGE(PG8_SB(0, 1), cB + hstep, voffB); PG8_STAGE(PG8_SA(0, 1), cA + hstep, voffA);
        if (wr == 1) PG8_BAR;
        PG8_WAIT_V(4); PG8_BAR;
        PG8_STAGE(PG8_SB(1, 0), cB + kstep, voffB); PG8_STAGE(PG8_SA(1, 0), cA + kstep, voffA); PG8_STAGE(PG8_SB(1, 1), cB + hstep + kstep, voffB);
        PG8_WAIT_V(6); PG8_BAR;
    }
    for (;;) {
        const bool has_next = S.next(ui + 1, nxt);
        const char* nA = has_next ? (const char*)g.A + (size_t)nxt.pm * tstep : cA; const char* nB = has_next ? (const char*)g.Bt + (size_t)nxt.pn * tstep : cB;
        for (int t = 0; t < nt; t += 2) {
            const bool last = (t == nt - 2);
            const char* a1 = cA + (size_t)(t + 1) * kstep;
            const char* a2 = last ? nA : cA + (size_t)(t + 2) * kstep; const char* b2 = last ? nB : cB + (size_t)(t + 2) * kstep;
            const char* a3 = a2 + kstep; const char* b3 = b2 + kstep;
            if (last && has_next) S.a_ready(nxt);
            if constexpr (SP2) {
            PG8_LDB(B0, 0, 0); PG8_LDB(B1, 0, 1); PG8_SCHED; PG8_LDA(At, 0, 0); PG8_STAGE(PG8_SA(1, 1), a1 + hstep, voffA);
            PG8_WAIT_V(8); PG8_WAIT_L(0); PG8_BAR; PG8_MMA(0, 0, At, B0); PG8_MMA(0, 1, At, B1); PG8_BAR; PG8_SCHED;
            PG8_LDA(At, 0, 1); PG8_STAGE(PG8_SB(0, 0), b2, voffB); PG8_STAGE(PG8_SB(0, 1), b2 + hstep, voffB); PG8_STAGE(PG8_SA(0, 0), a2, voffA);
            PG8_WAIT_V(8); PG8_WAIT_L(0); PG8_BAR; PG8_MMA(1, 0, At, B0); PG8_MMA(1, 1, At, B1); PG8_BAR; PG8_SCHED;
            PG8_LDB(B0, 1, 0); PG8_LDB(B1, 1, 1); PG8_SCHED; PG8_LDA(At, 1, 0); PG8_STAGE(PG8_SA(0, 1), a2 + hstep, voffA);
            PG8_WAIT_V(8); PG8_WAIT_L(0); PG8_BAR; PG8_MMA(0, 0, At, B0); PG8_MMA(0, 1, At, B1); PG8_BAR; PG8_SCHED;
            PG8_LDA(At, 1, 1); PG8_STAGE(PG8_SB(1, 0), b3, voffB); PG8_STAGE(PG8_SB(1, 1), b3 + hstep, voffB); PG8_STAGE(PG8_SA(1, 0), a3, voffA);
            PG8_WAIT_V(8); PG8_WAIT_L(0); PG8_BAR; PG8_MMA(1, 0, At, B0); PG8_MMA(1, 1, At, B1); PG8_BAR; PG8_SCHED;
            } else {
            PG8_LDB(B0, 0, 0); PG8_SCHED; PG8_LDA(At, 0, 0); PG8_STAGE(PG8_SA(1, 1), a1 + hstep, voffA);
            PG8_WAIT_L(8); PG8_BAR; PG8_WAIT_L(0); PG8_MMA(0, 0, At, B0); PG8_BAR; PG8_SCHED;
            PG8_LDB(B1, 0, 1); PG8_STAGE(PG8_SB(0, 0), b2, voffB);
            PG8_BAR; PG8_WAIT_L(0); PG8_MMA(0, 1, At, B1); PG8_BAR;
            PG8_LDA(At, 0, 1); PG8_STAGE(PG8_SA(0, 0), a2, voffA);
            PG8_BAR; PG8_WAIT_L(0); PG8_MMA(1, 0, At, B0); PG8_BAR; PG8_SCHED;
            PG8_STAGE(PG8_SB(0, 1), b2 + hstep, voffB);
            PG8_WAIT_V(6); PG8_BAR; PG8_MMA(1, 1, At, B1); PG8_BAR;
            PG8_LDB(B0, 1, 0); PG8_SCHED; PG8_LDA(At, 1, 0); PG8_STAGE(PG8_SA(0, 1), a2 + hstep, voffA);
            PG8_WAIT_L(8); PG8_BAR; PG8_WAIT_L(0); PG8_MMA(0, 0, At, B0); PG8_BAR; PG8_SCHED;
            PG8_LDB(B1, 1, 1); PG8_STAGE(PG8_SB(1, 0), b3, voffB);
            PG8_BAR; PG8_WAIT_L(0); PG8_MMA(0, 1, At, B1); PG8_BAR;
            PG8_LDA(At, 1, 1); PG8_STAGE(PG8_SA(1, 0), a3, voffA);
            PG8_BAR; PG8_WAIT_L(0); PG8_MMA(1, 0, At, B0); PG8_BAR; PG8_SCHED;
            PG8_STAGE(PG8_SB(1, 1), b3 + hstep, voffB);
            PG8_WAIT_V(6); PG8_BAR; PG8_MMA(1, 1, At, B1); PG8_BAR;
            }
        }
        if constexpr (ALIGN_EPI) { if (wr == 0) PG8_BAR; }
        if constexpr (!Epi::AFTER_DRAIN) { E(acc, cur, wr, wc, fr, fq); S.done(cur); }
        if (!has_next) break;
#pragma unroll
        for (int a = 0; a < 2; ++a)
#pragma unroll
            for (int b = 0; b < 2; ++b)
#pragma unroll
                for (int m = 0; m < 4; ++m)
#pragma unroll
                    for (int n = 0; n < 2; ++n) acc[a][b][m][n] = (f32x4){0.f, 0.f, 0.f, 0.f};
        cur = nxt; cA = nA; cB = nB; ++ui;
        if constexpr (ALIGN_EPI) { if (wr == 1) PG8_BAR; }
    }
    PG8_WAIT_V(0);
    if constexpr (!ALIGN_EPI) { if (wr == 0) PG8_BAR; }
    PG8_BAR;
    if constexpr (Epi::AFTER_DRAIN) { E.fused(acc, cur, wr, wc, fr, fq, lds, wid, lane); S.done(cur); }
#undef PG8_SA
#undef PG8_SB
#undef PG8_STAGE
#undef PG8_LDA
#undef PG8_LDB
#undef PG8_MMA
#undef PG8_WAIT_V
#undef PG8_WAIT_L
#undef PG8_BAR
#undef PG8_SCHED
}
}
namespace att {
#define LAS __attribute__((address_space(3)))
typedef unsigned short bf16_t;
typedef short bf16x8 __attribute__((ext_vector_type(8)));
typedef float f32x16 __attribute__((ext_vector_type(16)));
typedef float f32x4 __attribute__((ext_vector_type(4)));
typedef unsigned u32x4 __attribute__((ext_vector_type(4)));
typedef unsigned u32x2 __attribute__((ext_vector_type(2)));
constexpr float LOG2E = 1.4426950408889634f;
constexpr float NEG = -1.0e30f;
constexpr int LDQK = 5120;
__device__ __forceinline__ f32x16 mfma(bf16x8 a, bf16x8 b, f32x16 c) { return __builtin_amdgcn_mfma_f32_32x32x16_bf16(a, b, c, 0, 0, 0); }
__device__ __forceinline__ bf16x8 ld16(const bf16_t* p) { return *(const bf16x8*)p; }
__device__ __forceinline__ unsigned cvtpk(float lo, float hi) { typedef float f2 __attribute__((ext_vector_type(2))); typedef __bf16 b2 __attribute__((ext_vector_type(2))); f2 v = {lo, hi}; b2 b = __builtin_convertvector(v, b2); return __builtin_bit_cast(unsigned, b); }
__device__ __forceinline__ bf16x8 pack8(float a0, float a1, float a2, float a3, float a4, float a5, float a6, float a7) {
    u32x4 w; w.x = cvtpk(a0, a1); w.y = cvtpk(a2, a3); w.z = cvtpk(a4, a5); w.w = cvtpk(a6, a7); return __builtin_bit_cast(bf16x8, w); }
__device__ __forceinline__ float ex2(float x) { return __builtin_amdgcn_exp2f(x); }
__device__ __forceinline__ float lg2(float x) { return __builtin_amdgcn_logf(x); }
__device__ __forceinline__ int kperm(int m) { return ((m >> 4) << 4) | (((m >> 2) & 1) << 3) | (((m >> 3) & 1) << 2) | (m & 3); }
__device__ __forceinline__ int rel_bucket(int d) { if (d < 16) return d; const float lr = logf((float)d / 16.0f) / 4.852030263919617f; const int large = 16 + (int)(lr * 16.0f); return large < 31 ? large : 31; }
__device__ __forceinline__ float wsum(float v) {
#pragma unroll
    for (int o = 1; o < 64; o <<= 1) v += __shfl_xor(v, o);
    return v; }
#define KL(r, hi) (16 * ((r) >> 3) + 8 * (hi) + ((r) & 7))

__device__ __forceinline__ void attnA_unit(LAS float* tbl, const bf16_t* QK, const bf16_t* VT, bf16_t* ODA, int Mc, int b, int h, int p,
                                           const float* lam4, const float* normg, const float* relb, float lam_init, int tid, int wave, int lane) {
    __syncthreads();
    for (int d = tid; d < 4096; d += 512) tbl[d] = relb[rel_bucket(d) * 16 + h] * LOG2E;
    const float s0 = wsum(lam4[lane] * lam4[64 + lane]), s1 = wsum(lam4[128 + lane] * lam4[192 + lane]);
    const float lam = expf(s0) - expf(s1) + lam_init;
    __syncthreads();
    const int hi = lane >> 5, ql = lane & 31;
    const int sb = (wave < 4) ? (4 * p + wave) : (4 * (31 - p) + 3 - (wave - 4));
    const int qpos = sb * 32 + ql;
    const size_t tokbase = (size_t)b * 4096;
    const float SC = 0.125f * LOG2E;
    const bf16_t* qrow = QK + (tokbase + qpos) * LDQK + h * 128 + hi * 8;
    bf16x8 qf[2][4];
#pragma unroll
    for (int mp = 0; mp < 2; ++mp)
#pragma unroll
        for (int st = 0; st < 4; ++st) qf[mp][st] = ld16(qrow + mp * 64 + st * 16);
    const bf16_t* kbase = QK + (tokbase + kperm(ql)) * LDQK + 512 + h * 128 + hi * 8;
    float mx[2] = {NEG, NEG}, sm[2] = {0.f, 0.f};
    for (int j = 0; j <= sb; ++j) {
        const bf16_t* kr = kbase + (size_t)(j * 32) * LDQK;
        const int dbase = qpos - j * 32 - 8 * hi;
        float bias[16];
#pragma unroll
        for (int r = 0; r < 16; ++r) { const int d = dbase - (r & 7) - 16 * (r >> 3); bias[r] = tbl[d > 0 ? d : 0]; }
#pragma unroll
        for (int mp = 0; mp < 2; ++mp) {
            f32x16 s = {0.f, 0.f, 0.f, 0.f, 0.f, 0.f, 0.f, 0.f, 0.f, 0.f, 0.f, 0.f, 0.f, 0.f, 0.f, 0.f};
#pragma unroll
            for (int st = 0; st < 4; ++st) s = mfma(ld16(kr + mp * 64 + st * 16), qf[mp][st], s);
            float mt = NEG;
#pragma unroll
            for (int r = 0; r < 16; ++r) { const int d = dbase - (r & 7) - 16 * (r >> 3); const float v = d >= 0 ? s[r] * SC + bias[r] : NEG; s[r] = v; mt = fmaxf(mt, v); }
            const float mn = fmaxf(mx[mp], mt); float a = 0.f;
#pragma unroll
            for (int r = 0; r < 16; ++r) a += ex2(s[r] - mn);
            sm[mp] = sm[mp] * ex2(mx[mp] - mn) + a; mx[mp] = mn;
        }
    }
    float Mf[2], iL[2];
#pragma unroll
    for (int mp = 0; mp < 2; ++mp) { const float mo = __shfl_xor(mx[mp], 32), so = __shfl_xor(sm[mp], 32); const float M = fmaxf(mx[mp], mo);
        const float L = sm[mp] * ex2(mx[mp] - M) + so * ex2(mo - M); Mf[mp] = M; iL[mp] = 1.0f / L; }
    const float c0 = iL[0], c1 = lam * iL[1];
    f32x16 O[4];
#pragma unroll
    for (int k = 0; k < 4; ++k) O[k] = (f32x16){0.f, 0.f, 0.f, 0.f, 0.f, 0.f, 0.f, 0.f, 0.f, 0.f, 0.f, 0.f, 0.f, 0.f, 0.f, 0.f};
    const bf16_t* vbase = VT + (size_t)(h * 128 + ql) * Mc + tokbase + 8 * hi;
    for (int j = 0; j <= sb; ++j) {
        const bf16_t* kr = kbase + (size_t)(j * 32) * LDQK;
        const int dbase = qpos - j * 32 - 8 * hi;
        f32x16 s0v = {0.f, 0.f, 0.f, 0.f, 0.f, 0.f, 0.f, 0.f, 0.f, 0.f, 0.f, 0.f, 0.f, 0.f, 0.f, 0.f}, s1v = s0v;
#pragma unroll
        for (int st = 0; st < 4; ++st) { s0v = mfma(ld16(kr + st * 16), qf[0][st], s0v); s1v = mfma(ld16(kr + 64 + st * 16), qf[1][st], s1v); }
        float w[16];
#pragma unroll
        for (int r = 0; r < 16; ++r) { const int d = dbase - (r & 7) - 16 * (r >> 3); const float bb = tbl[d > 0 ? d : 0];
            const float e0 = ex2(s0v[r] * SC + bb - Mf[0]), e1 = ex2(s1v[r] * SC + bb - Mf[1]);
            w[r] = d >= 0 ? (e0 * c0 - e1 * c1) : 0.f; }
        const bf16x8 pb0 = pack8(w[0], w[1], w[2], w[3], w[4], w[5], w[6], w[7]), pb1 = pack8(w[8], w[9], w[10], w[11], w[12], w[13], w[14], w[15]);
        const bf16_t* vr = vbase + j * 32;
#pragma unroll
        for (int k = 0; k < 4; ++k) { O[k] = mfma(ld16(vr + (size_t)(k * 32) * Mc), pb0, O[k]); O[k] = mfma(ld16(vr + (size_t)(k * 32) * Mc + 16), pb1, O[k]); }
    }
    float ss = 0.f;
#pragma unroll
    for (int k = 0; k < 4; ++k)
#pragma unroll
        for (int r = 0; r < 16; ++r) ss += O[k][r] * O[k][r];
    ss += __shfl_xor(ss, 32);
    const float rs = (1.0f / sqrtf(ss * (1.0f / 128.0f) + 1e-5f)) * (1.0f - lam_init);
    bf16_t* orow = ODA + (tokbase + qpos) * 512 + h * 128 + 4 * hi;
#pragma unroll
    for (int k = 0; k < 4; ++k)
#pragma unroll
        for (int rr = 0; rr < 4; ++rr) { const int dv = 32 * k + 8 * rr; const f32x4 g = *(const f32x4*)(normg + dv + 4 * hi);
            u32x2 o; o.x = cvtpk(O[k][4 * rr] * rs * g[0], O[k][4 * rr + 1] * rs * g[1]); o.y = cvtpk(O[k][4 * rr + 2] * rs * g[2], O[k][4 * rr + 3] * rs * g[3]);
            *(u32x2*)(orow + dv) = o; }
}

__device__ __forceinline__ void attnB_unit(const bf16_t* QK, const bf16_t* VT, bf16_t* OSB, int Mc, int b, int h, int qb, int wave, int lane) {
    const int hi = lane >> 5, ql = lane & 31;
    const int sb = qb * 8 + wave; const int qpos = sb * 32 + ql;
    const size_t tokbase = (size_t)b * 4096;
    const float SC = 0.125f * LOG2E;
    const bf16_t* qrow = QK + (tokbase + qpos) * LDQK + 1024 + h * 64 + hi * 8;
    bf16x8 qf[4];
#pragma unroll
    for (int st = 0; st < 4; ++st) qf[st] = ld16(qrow + st * 16);
    const bf16_t* kbase = QK + (tokbase + kperm(ql)) * LDQK + 1536 + h * 64 + hi * 8;
    const bf16_t* vbase = VT + (size_t)(512 + h * 64 + ql) * Mc + tokbase + 8 * hi;
    f32x16 O[2];
#pragma unroll
    for (int k = 0; k < 2; ++k) O[k] = (f32x16){0.f, 0.f, 0.f, 0.f, 0.f, 0.f, 0.f, 0.f, 0.f, 0.f, 0.f, 0.f, 0.f, 0.f, 0.f, 0.f};
    float carry = 0.f;
    for (int j = sb; j >= 0; --j) {
        const bf16_t* kr = kbase + (size_t)(j * 32) * LDQK;
        f32x16 s = {0.f, 0.f, 0.f, 0.f, 0.f, 0.f, 0.f, 0.f, 0.f, 0.f, 0.f, 0.f, 0.f, 0.f, 0.f, 0.f};
#pragma unroll
        for (int st = 0; st < 4; ++st) s = mfma(ld16(kr + st * 16), qf[st], s);
        const int dbase = qpos - j * 32 - 8 * hi;
        float lk[16], zz[16];
#pragma unroll
        for (int r = 0; r < 16; ++r) { const int d = dbase - (r & 7) - 16 * (r >> 3); const float z2 = s[r] * SC;
            const float sp = fmaxf(z2, 0.f) + lg2(1.0f + ex2(-fabsf(z2)));
            lk[r] = d > 0 ? -sp : 0.f; zz[r] = d > 0 ? z2 : NEG; }
        float sf[16]; float T0 = 0.f, T1 = 0.f;
#pragma unroll
        for (int r = 7; r >= 0; --r) { sf[r] = T0; T0 += lk[r]; }
#pragma unroll
        for (int r = 15; r >= 8; --r) { sf[r] = T1; T1 += lk[r]; }
        const float P0 = __shfl_xor(T0, 32), P1 = __shfl_xor(T1, 32);
        const float add0 = carry + (hi == 0 ? (P0 + T1 + P1) : (P1 + T1));
        const float add1 = carry + (hi == 0 ? P1 : 0.f);
        float a[16];
#pragma unroll
        for (int r = 0; r < 16; ++r) a[r] = ex2(zz[r] + lk[r] + sf[r] + (r < 8 ? add0 : add1));
        const bf16x8 pb0 = pack8(a[0], a[1], a[2], a[3], a[4], a[5], a[6], a[7]), pb1 = pack8(a[8], a[9], a[10], a[11], a[12], a[13], a[14], a[15]);
        const bf16_t* vr = vbase + j * 32;
#pragma unroll
        for (int k = 0; k < 2; ++k) { O[k] = mfma(ld16(vr + (size_t)(k * 32) * Mc), pb0, O[k]); O[k] = mfma(ld16(vr + (size_t)(k * 32) * Mc + 16), pb1, O[k]); }
        carry += (T0 + T1) + (P0 + P1);
        if (__all(carry < -160.0f)) break;
    }
    bf16_t* orow = OSB + (tokbase + qpos) * 512 + h * 64 + 4 * hi;
#pragma unroll
    for (int k = 0; k < 2; ++k)
#pragma unroll
        for (int rr = 0; rr < 4; ++rr) { u32x2 o; o.x = cvtpk(O[k][4 * rr], O[k][4 * rr + 1]); o.y = cvtpk(O[k][4 * rr + 2], O[k][4 * rr + 3]); *(u32x2*)(orow + 32 * k + 8 * rr) = o; }
}

__device__ __forceinline__ void attnC_unit(LAS float* tblC, const bf16_t* QK, const bf16_t* VT, float* SCR, float* LSE, bf16_t* ODL, int Mc, int b, int hh, int R,
                                           const float* relb, int tid, int wave, int lane) {
    __syncthreads();
    for (int i = tid; i < 3 * 129; i += 512) { const int g = i / 129, j = i - g * 129; tblC[g * 132 + j] = relb[rel_bucket(j << (2 * g)) * 16 + 4 + g * 4 + hh] * LOG2E; }
    __syncthreads();
    const int hi = lane >> 5, ql = lane & 31;
    const size_t tokbase = (size_t)b * 4096;
    const float SC = 0.08838834764831845f * LOG2E;
#pragma unroll 1
    for (int g = 0; g < 3; ++g) {
        const int ld = 2 * g, nmb = 16 >> ld;
#pragma unroll 1
        for (int tt = 0; tt < 2; ++tt) {
            const int t = wave * 2 + tt; const int res = t / nmb, mb = t - res * nmb;
            const int m0 = R * (512 >> ld) + 32 * mb;
            const int token = ((m0 + ql) << ld) + res;
            const bf16_t* qrow = QK + (tokbase + token) * LDQK + 2048 + g * 512 + hh * 128 + hi * 8;
            bf16x8 qf[8];
#pragma unroll
            for (int st = 0; st < 8; ++st) qf[st] = ld16(qrow + st * 16);
            f32x16 S[5];
            float mt = NEG;
#pragma unroll
            for (int jt = 0; jt < 5; ++jt) {
                const int mt0 = m0 - 128 + 32 * jt;
                f32x16 s = {0.f, 0.f, 0.f, 0.f, 0.f, 0.f, 0.f, 0.f, 0.f, 0.f, 0.f, 0.f, 0.f, 0.f, 0.f, 0.f};
                if (mt0 >= 0) {
                    const int ktok = ((mt0 + kperm(ql)) << ld) + res;
                    const bf16_t* kr = QK + (tokbase + ktok) * LDQK + 3584 + g * 512 + hh * 128 + hi * 8;
#pragma unroll
                    for (int st = 0; st < 8; ++st) s = mfma(ld16(kr + st * 16), qf[st], s);
                }
#pragma unroll
                for (int r = 0; r < 16; ++r) { const int jd = 128 - 32 * jt + ql - KL(r, hi);
                    const bool ok = (mt0 >= 0) && (jd >= 0) && (jd <= 128);
                    const float v = ok ? s[r] * SC + tblC[g * 132 + (jd < 0 ? 0 : (jd > 128 ? 128 : jd))] : NEG; s[r] = v; mt = fmaxf(mt, v); }
                S[jt] = s;
                asm volatile("" ::: "memory");
            }
            const float M = fmaxf(mt, __shfl_xor(mt, 32));
            float L = 0.f;
#pragma unroll
            for (int jt = 0; jt < 5; ++jt)
#pragma unroll
                for (int r = 0; r < 16; ++r) { const float e = ex2(S[jt][r] - M); S[jt][r] = e; L += e; }
            L += __shfl_xor(L, 32);
            const float iL = 1.0f / L;
            f32x16 O[4];
#pragma unroll
            for (int k = 0; k < 4; ++k) O[k] = (f32x16){0.f, 0.f, 0.f, 0.f, 0.f, 0.f, 0.f, 0.f, 0.f, 0.f, 0.f, 0.f, 0.f, 0.f, 0.f, 0.f};
            const bf16_t* vbase = VT + (size_t)(1024 + g * 512 + hh * 128 + ql) * Mc + tokbase + res * (4096 >> ld) + 8 * hi;
#pragma unroll
            for (int jt = 0; jt < 5; ++jt) {
                const int mt0 = m0 - 128 + 32 * jt;
                if (mt0 >= 0) {
                    const bf16x8 pb0 = pack8(S[jt][0] * iL, S[jt][1] * iL, S[jt][2] * iL, S[jt][3] * iL, S[jt][4] * iL, S[jt][5] * iL, S[jt][6] * iL, S[jt][7] * iL);
                    const bf16x8 pb1 = pack8(S[jt][8] * iL, S[jt][9] * iL, S[jt][10] * iL, S[jt][11] * iL, S[jt][12] * iL, S[jt][13] * iL, S[jt][14] * iL, S[jt][15] * iL);
                    const bf16_t* vr = vbase + mt0;
#pragma unroll
                    for (int k = 0; k < 4; ++k) { O[k] = mfma(ld16(vr + (size_t)(k * 32) * Mc), pb0, O[k]); O[k] = mfma(ld16(vr + (size_t)(k * 32) * Mc + 16), pb1, O[k]); }
                }
                asm volatile("" ::: "memory");
            }
            float lse = M + lg2(L);
            float* srow = SCR + (tokbase + token) * 512 + hh * 128 + 4 * hi;
            float* lp = LSE + (tokbase + token) * 4 + hh;
            if (g > 0) {
                const float lo = *lp; const float mxl = fmaxf(lo, lse);
                const float ea = ex2(lo - mxl), eb = ex2(lse - mxl); const float inv = 1.0f / (ea + eb);
                const float wa = ea * inv, wb = eb * inv; lse = mxl + lg2(ea + eb);
#pragma unroll
                for (int k = 0; k < 4; ++k)
#pragma unroll
                    for (int rr = 0; rr < 4; ++rr) { const f32x4 old = *(const f32x4*)(srow + 32 * k + 8 * rr);
#pragma unroll
                        for (int e = 0; e < 4; ++e) O[k][4 * rr + e] = wa * old[e] + wb * O[k][4 * rr + e]; }
            }
            if (g < 2) {
#pragma unroll
                for (int k = 0; k < 4; ++k)
#pragma unroll
                    for (int rr = 0; rr < 4; ++rr) *(f32x4*)(srow + 32 * k + 8 * rr) = (f32x4){O[k][4 * rr], O[k][4 * rr + 1], O[k][4 * rr + 2], O[k][4 * rr + 3]};
                if (hi == 0) *lp = lse;
            } else {
                bf16_t* orow = ODL + (tokbase + token) * 512 + hh * 128 + 4 * hi;
#pragma unroll
                for (int k = 0; k < 4; ++k)
#pragma unroll
                    for (int rr = 0; rr < 4; ++rr) { u32x2 o; o.x = cvtpk(O[k][4 * rr], O[k][4 * rr + 1]); o.y = cvtpk(O[k][4 * rr + 2], O[k][4 * rr + 3]); *(u32x2*)(orow + 32 * k + 8 * rr) = o; }
            }
        }
        if (g < 2) __syncthreads();
    }
}
}
constexpr int MTOK = 32768, DM = 1024, DFF = 4096, NPROJ = 10752, MC = 16384, NLAYER = 4;
constexpr size_t MiB = 1u << 20;
constexpr size_t WS_WIN = 1 * MiB, WS_WBR = 22 * MiB, WS_WOUT = 25 * MiB, WS_WUP = 27 * MiB, WS_WDOWN = 35 * MiB, WS_WG = 43 * MiB, WS_WP = 45 * MiB;
constexpr size_t WS_PB = 46 * MiB, WS_XB = 62 * MiB, WS_QK = 126 * MiB, WS_VT = 286 * MiB, WS_GT = 366 * MiB, WS_HID = 126 * MiB;
constexpr size_t WS_ODA = 462 * MiB, WS_OSB = 478 * MiB, WS_ODL = 494 * MiB, WS_SCR = 510 * MiB, WS_LSE = 542 * MiB, WS_MF = 543 * MiB, WS_MRG = 607 * MiB, WS_TMP = 462 * MiB, WS_END = 639 * MiB;
constexpr int LDS_BYTES = 143360;
constexpr float ALPHA = 1.681792830507429f;
typedef unsigned short bf16;
typedef unsigned v4u __attribute__((ext_vector_type(4)));
typedef float f32x4 __attribute__((ext_vector_type(4)));
__device__ __forceinline__ unsigned pk2(float lo, float hi) { return pg8::cvt_pk_bf16(lo, hi); }
__device__ __forceinline__ float wave_sum(float v) {
#pragma unroll
    for (int o = 1; o < 64; o <<= 1) v += __shfl_xor(v, o);
    return v; }
__device__ __forceinline__ void transpose_item(const float* W, int K, int N, bf16* WT, LAS float* scr, int item, int lane) {
    const int nblk = N / 32, kb = item / nblk, nb = item - kb * nblk, k0 = 64 * kb, n0 = 32 * nb;
#pragma unroll 8
    for (int i = 0; i < 32; ++i) { const int kk = 2 * i + (lane >> 5); scr[kk * 33 + (lane & 31)] = W[(size_t)(k0 + kk) * N + n0 + (lane & 31)]; }
    asm volatile("s_waitcnt lgkmcnt(0)" ::: "memory");
    const int c = lane & 7;
#pragma unroll
    for (int j = 0; j < 4; ++j) { const int n = (lane >> 3) + 8 * j; const LAS float* s = scr + (8 * c) * 33 + n;
        v4u o; o.x = pk2(s[0 * 33], s[1 * 33]); o.y = pk2(s[2 * 33], s[3 * 33]); o.z = pk2(s[4 * 33], s[5 * 33]); o.w = pk2(s[6 * 33], s[7 * 33]);
        *(v4u*)(WT + (size_t)(n0 + n) * K + k0 + 8 * c) = o; }
    asm volatile("s_waitcnt lgkmcnt(0)" ::: "memory");
}
struct Args { const float* in[18]; float* out; unsigned char* ws; };
constexpr int PTAB_OFF = 131072 + 4096;
__device__ __forceinline__ const float* ldptr(LAS unsigned char* lds, int i) {
    const unsigned long long v = ((LAS unsigned long long*)(lds + PTAB_OFF))[i];
    const unsigned lo = __builtin_amdgcn_readfirstlane((unsigned)v), hi = __builtin_amdgcn_readfirstlane((unsigned)(v >> 32));
    return (const float*)(((unsigned long long)hi << 32) | lo); }
__device__ __forceinline__ void convert_layer(unsigned char* ws, int layer, LAS unsigned char* lds, int gw, int NGW, int wave, int lane) {
    LAS float* scr = (LAS float*)(lds + wave * 16384);
    constexpr int I_IN = 16 * 336, I_BR = 8 * 32, I_O = 16 * 32, I_UP = 16 * 128, I_DN = 64 * 32, I_G = 16 * 32, I_P = 4 * 32;
    constexpr int NIT = I_IN + 3 * I_BR + I_O + I_UP + I_DN + I_G + I_P;
    for (int it = gw; it < NIT; it += NGW) {
        int r = it;
        if (r < I_IN) { transpose_item(ldptr(lds, 2) + (size_t)layer * 1024 * NPROJ, 1024, NPROJ, (bf16*)(ws + WS_WIN), scr, r, lane); continue; } r -= I_IN;
        if (r < 3 * I_BR) { const int br = r / I_BR; transpose_item(ldptr(lds, 5 + br) + (size_t)layer * 512 * 1024, 512, 1024, (bf16*)(ws + WS_WBR) + (size_t)br * 1024 * 512, scr, r - br * I_BR, lane); continue; } r -= 3 * I_BR;
        if (r < I_O) { transpose_item(ldptr(lds, 8) + (size_t)layer * 1024 * 1024, 1024, 1024, (bf16*)(ws + WS_WOUT), scr, r, lane); continue; } r -= I_O;
        if (r < I_UP) { transpose_item(ldptr(lds, 11) + (size_t)layer * 1024 * 4096, 1024, 4096, (bf16*)(ws + WS_WUP), scr, r, lane); continue; } r -= I_UP;
        if (r < I_DN) { transpose_item(ldptr(lds, 12) + (size_t)layer * 4096 * 1024, 4096, 1024, (bf16*)(ws + WS_WDOWN), scr, r, lane); continue; } r -= I_DN;
        if (r < I_G) { transpose_item(ldptr(lds, 13) + (size_t)layer * 1024 * 1024, 1024, 1024, (bf16*)(ws + WS_WG), scr, r, lane); continue; } r -= I_G;
        transpose_item(ldptr(lds, 14) + (size_t)layer * 256 * 1024, 256, 1024, (bf16*)(ws + WS_WP), scr, r, lane);
    }
    const float* ps = ldptr(lds, 1) + (size_t)layer * MTOK * 256; bf16* pd = (bf16*)(ws + WS_PB);
    for (size_t i = (size_t)gw * 64 + lane; i < (size_t)MTOK * 256 / 8; i += (size_t)NGW * 64) {
        const f32x4 u = *(const f32x4*)(ps + i * 8), v = *(const f32x4*)(ps + i * 8 + 4);
        v4u o; o.x = pk2(u[0], u[1]); o.y = pk2(u[2], u[3]); o.z = pk2(v[0], v[1]); o.w = pk2(v[2], v[3]); *(v4u*)(pd + i * 8) = o; }
}
__device__ __forceinline__ void ln_pass(float* Y, bf16* XB, const float* g, const float* bt, int gw, int NGW, int lane) {
    for (int m = gw; m < MTOK; m += NGW) {
        f32x4* yr = (f32x4*)(Y + (size_t)m * DM) + lane;
        f32x4 v[4]; float s = 0.f;
#pragma unroll
        for (int j = 0; j < 4; ++j) { v[j] = yr[64 * j]; s += (v[j][0] + v[j][1]) + (v[j][2] + v[j][3]); }
        const float mean = wave_sum(s) * (1.f / DM); float s2 = 0.f;
#pragma unroll
        for (int j = 0; j < 4; ++j) { v[j] = v[j] - mean; s2 += (v[j][0] * v[j][0] + v[j][1] * v[j][1]) + (v[j][2] * v[j][2] + v[j][3] * v[j][3]); }
        const float rstd = 1.f / sqrtf(wave_sum(s2) * (1.f / DM) + 1e-5f);
        unsigned long long* o8 = (unsigned long long*)(XB + (size_t)m * DM) + lane;
#pragma unroll
        for (int j = 0; j < 4; ++j) { const f32x4 gv = ((const f32x4*)g)[lane + 64 * j], bv = ((const f32x4*)bt)[lane + 64 * j];
            const f32x4 o = v[j] * rstd * gv + bv; yr[64 * j] = o;
            o8[64 * j] = (unsigned long long)pk2(o[0], o[1]) | ((unsigned long long)pk2(o[2], o[3]) << 32); }
    }
}

__global__ void __launch_bounds__(512, 2) mk_fwd(Args a) {
    extern __shared__ __attribute__((aligned(16))) unsigned char lds_raw[];
    LAS unsigned char* lds = (LAS unsigned char*)lds_raw;
    cg::grid_group grid = cg::this_grid();
    const int tid0 = threadIdx.x;
    const int G = gridDim.x, bid0 = blockIdx.x;
    const int NGW = G * 8;
    if (tid0 == 0) { LAS unsigned long long* pt = (LAS unsigned long long*)(lds + PTAB_OFF);
#pragma unroll
        for (int i = 0; i < 18; ++i) pt[i] = (unsigned long long)a.in[i]; }
    __syncthreads();
    { const int lane = tid0 & 63, wave = __builtin_amdgcn_readfirstlane(tid0 >> 6), gw = bid0 * 8 + wave; unsigned char* ws = a.ws; bf16* XB = (bf16*)(ws + WS_XB);
      convert_layer(ws, 0, lds, gw, NGW, wave, lane);
      const float* xs = ldptr(lds, 0);
      for (size_t i = (size_t)gw * 64 + lane; i < (size_t)MTOK * DM / 8; i += (size_t)NGW * 64) {
          const f32x4 u = *(const f32x4*)(xs + i * 8), v = *(const f32x4*)(xs + i * 8 + 4);
          v4u o; o.x = pk2(u[0], u[1]); o.y = pk2(u[2], u[3]); o.z = pk2(v[0], v[1]); o.w = pk2(v[2], v[3]); *(v4u*)(XB + i * 8) = o; } }
    grid.sync();
    for (int step = 0; step < NLAYER * 18; ++step) {
        const int layer = step / 18, s = step - layer * 18;
        int tid = tid0; asm volatile("" : "+v"(tid));
        const int lane = tid & 63, wave = __builtin_amdgcn_readfirstlane(tid >> 6);
        int bid = bid0; asm volatile("" : "+s"(bid));
        const int gw = bid * 8 + wave;
        unsigned char* ws = a.ws; asm volatile("" : "+s"(ws));
        float* outp = a.out; asm volatile("" : "+s"(outp));
        bf16* XB = (bf16*)(ws + WS_XB);
        int kind = 3; bool sync = true;
        pg8::Gemm g{nullptr, nullptr, 0, 0, 0};
        pg8::EpiB EB{0, (bf16*)(ws + WS_QK), (bf16*)(ws + WS_VT), (bf16*)(ws + WS_GT), (bf16*)(ws + WS_HID), MC};
        pg8::EpiF EF{0, nullptr, nullptr, outp, (const bf16*)(ws + WS_GT), (bf16*)(ws + WS_MRG), 0, 0, ALPHA};
        int chunk = 0;
        if (s < 12) {
            chunk = s / 6; const int k = s - chunk * 6;
            if (k == 0) { kind = 0; g = pg8::Gemm{XB + (size_t)chunk * MC * DM, (const bf16*)(ws + WS_WIN), MC, NPROJ, DM}; EB.mode = 0; }
            else if (k == 1) { kind = 2; }
            else if (k <= 4) { kind = 1; const int br = k - 2; sync = (k == 4);
                g = pg8::Gemm{(const bf16*)(ws + WS_ODA + (size_t)br * 16 * MiB), (const bf16*)(ws + WS_WBR) + (size_t)br * 1024 * 512, MC, DM, 512};
                EF.mode = br; EF.F = (float*)(ws + WS_MF); EF.gofs = br * 1024; }
            else { kind = 1; sync = (chunk == 1);
                g = pg8::Gemm{(const bf16*)(ws + WS_MRG), (const bf16*)(ws + WS_WOUT), MC, DM, DM};
                EF.mode = 3; EF.X = (layer == 0) ? ldptr(lds, 0) : outp; EF.rowoff = chunk * MC; }
        } else if (s == 12) { kind = 3; }
        else if (s == 13) { kind = 0; sync = false; g = pg8::Gemm{XB, (const bf16*)(ws + WS_WUP), MTOK, DFF, DM}; EB.mode = 1; }
        else if (s == 14) { kind = 1; sync = false; g = pg8::Gemm{XB, (const bf16*)(ws + WS_WG), MTOK, DM, DM}; EF.mode = 4; EF.F = (float*)(ws + WS_TMP); }
        else if (s == 15) { kind = 1; g = pg8::Gemm{(const bf16*)(ws + WS_PB), (const bf16*)(ws + WS_WP), MTOK, DM, 256}; EF.mode = 5; EF.F = (float*)(ws + WS_TMP); }
        else if (s == 16) { kind = 1; g = pg8::Gemm{(const bf16*)(ws + WS_HID), (const bf16*)(ws + WS_WDOWN), MTOK, DM, DFF}; EF.mode = 6; }
        else { kind = 4; }

#ifndef NO_GEMMB
        if (kind == 0) { pg8::StaticOrder S; S.init(g.M, g.N, G, bid); pg8::gemm_phase<pg8::EpiB, pg8::StaticOrder, true, true>(lds, g, S, EB, tid); }
#else
        if (0) {}
#endif
#ifndef NO_GEMMF
        else if (kind == 1) { pg8::StaticOrder S; S.init(g.M, g.N, G, bid); pg8::gemm_phase<pg8::EpiF, pg8::StaticOrder, true, true>(lds, g, S, EF, tid); }
#endif
#ifndef NO_ATT
        else if (kind == 2) {
            const bf16* QK = (const bf16*)(ws + WS_QK); const bf16* VT = (const bf16*)(ws + WS_VT);
            const float lam_init = 0.8f - 0.6f * expf(-0.3f * (float)layer);
#ifndef NO_A
            for (int u = bid; u < 256; u += G)
                att::attnA_unit((LAS float*)lds, QK, VT, (bf16*)(ws + WS_ODA), MC, u >> 6, (u >> 4) & 3, u & 15, ldptr(lds, 3) + layer * 256, ldptr(lds, 4) + layer * 128, ldptr(lds, 17), lam_init, tid, wave, lane);
#endif
#ifndef NO_C
            for (int u = bid; u < 128; u += G)
                att::attnC_unit((LAS float*)(lds + 16384), QK, VT, (float*)(ws + WS_SCR), (float*)(ws + WS_LSE), (bf16*)(ws + WS_ODL), MC, u >> 5, (u >> 3) & 3, u & 7, ldptr(lds, 17), tid, wave, lane);
#endif
#ifndef NO_B
            if (G > 128) { if (bid >= 128) for (int u = bid - 128; u < 512; u += G - 128) att::attnB_unit(QK, VT, (bf16*)(ws + WS_OSB), MC, u >> 7, (u >> 4) & 7, u & 15, wave, lane); }
            else for (int u = bid; u < 512; u += G) att::attnB_unit(QK, VT, (bf16*)(ws + WS_OSB), MC, u >> 7, (u >> 4) & 7, u & 15, wave, lane);
#endif
        }
#endif
        else if (kind == 3) { ln_pass(outp, XB, ldptr(lds, 9) + layer * DM, ldptr(lds, 10) + layer * DM, gw, NGW, lane); }
        else { ln_pass(outp, XB, ldptr(lds, 15) + layer * DM, ldptr(lds, 16) + layer * DM, gw, NGW, lane);
               if (layer + 1 < NLAYER) convert_layer(ws, layer + 1, lds, gw, NGW, wave, lane); }
        if (sync && step + 1 < NLAYER * 18) grid.sync();
    }
}

extern "C" void kernel_launch(void* const* d_in, const int* in_sizes, int n_in, void* d_out, int out_size, void* d_ws, size_t ws_size, hipStream_t stream) {
    static int grid = 0;
    if (grid == 0) {
        if (n_in != 18 || out_size != MTOK * DM || ws_size < WS_END) { fprintf(stderr, "kernel_launch: unexpected shapes (n_in %d out %d ws %zu)\n", n_in, out_size, ws_size); grid = -1; return; }
        int dev = 0, cus = 0, per_cu = 0;
        (void)hipGetDevice(&dev); (void)hipDeviceGetAttribute(&cus, hipDeviceAttributeMultiprocessorCount, dev);
        if (hipFuncSetAttribute((const void*)mk_fwd, hipFuncAttributeMaxDynamicSharedMemorySize, LDS_BYTES) != hipSuccess) { fprintf(stderr, "hipFuncSetAttribute failed\n"); grid = -1; return; }
        if (hipOccupancyMaxActiveBlocksPerMultiprocessor(&per_cu, (const void*)mk_fwd, 512, LDS_BYTES) != hipSuccess || per_cu < 1) { fprintf(stderr, "occupancy query says %d\n", per_cu); per_cu = 1; }
        (void)hipGetLastError();
        grid = cus;
    }
    if (grid < 0) return;
    Args a{};
    for (int i = 0; i < 18; ++i) a.in[i] = (const float*)d_in[i];
    a.out = (float*)d_out; a.ws = (unsigned char*)d_ws;
    void* args[] = {&a};
    hipError_t e = hipLaunchCooperativeKernel((const void*)mk_fwd, dim3(grid), dim3(512), args, LDS_BYTES, stream);
    if (e != hipSuccess) fprintf(stderr, "cooperative launch failed: %s (grid %d)\n", hipGetErrorString(e), grid);
}
```

```cpp
#include <hip/hip_runtime.h>
#include <hip/hip_cooperative_groups.h>
#include <cstdio>
#include <cstdint>
#include <cmath>
namespace cg = cooperative_groups;
namespace pg8 {
#define PG8_LAS __attribute__((address_space(3)))
typedef unsigned short bf16_t;
typedef short bf16x8 __attribute__((ext_vector_type(8)));
typedef float f32x4 __attribute__((ext_vector_type(4)));
typedef unsigned u32x4 __attribute__((ext_vector_type(4)));
constexpr int BM = 256, BK = 64, HALF = 128, HTB = HALF * BK * 2  , STAGE_BYTES = 8 * HTB, NXCD = 8, WGM = 8;

__host__ __device__ __forceinline__ int lds_byte(int r, int c) { const int st = (r >> 4) * 2 + (c >> 5), rr = r & 15, cc = c & 31, ob = rr * 64 + cc * 2; return st * 1024 + (ob ^ (((ob >> 9) & 1) << 5)); }
__host__ __device__ __forceinline__ void stage_rc(int b, int& R, int& C) { const int st = b / 1024, sb = b % 1024, swz = sb ^ (((sb >> 9) & 1) << 5); R = (st >> 1) * 16 + swz / 64; C = (st & 1) * 32 + (swz % 64) / 2; }
__host__ __device__ __forceinline__ int perm32(int rho) { const int n = rho >> 4, i = rho & 15; return 8 * (i >> 2) + 4 * n + (i & 3); }

struct Unit { int pm, pn; };
struct Gemm { const bf16_t* A; const bf16_t* Bt; int M, N, K; };

struct StaticOrder {
    int nM, nN, nwg, G, c;
    __host__ __device__ void init(int M, int N, int G_, int c_) { nM = M / BM; nN = N / BM; nwg = nM * nN; G = G_; c = c_; }
    __host__ __device__ bool next(int i, Unit& u) const {
        const long L = (long)i * G + c; if (L >= nwg) return false;
        int wgid = (int)L; { const int q = nwg / NXCD, r = nwg % NXCD, xcd = wgid % NXCD, off = wgid / NXCD; wgid = (xcd < r ? xcd * (q + 1) : r * (q + 1) + (xcd - r) * q) + off; }
        const int nig = WGM * nN, gid = wgid / nig, fm = gid * WGM, gsz = (nM - fm) < WGM ? (nM - fm) : WGM;
        u.pm = fm + ((wgid % nig) % gsz); u.pn = (wgid % nig) / gsz; return true;
    }
    __device__ __forceinline__ void a_ready(const Unit&) const {}
    __device__ __forceinline__ void done(const Unit&) const {}
};

__device__ __forceinline__ unsigned cvt_pk_bf16(float lo, float hi) { unsigned r; asm volatile("v_cvt_pk_bf16_f32 %0, %1, %2" : "=v"(r) : "v"(lo), "v"(hi)); return r; }
typedef float f32x2 __attribute__((ext_vector_type(2)));
typedef unsigned u32x2 __attribute__((ext_vector_type(2)));
__device__ __forceinline__ float fsigmoid(float x) { return __builtin_amdgcn_rcpf(1.0f + __expf(-x)); }

struct EpiB {
    static constexpr bool PERM = true, AFTER_DRAIN = false;
    int mode; bf16_t* QK; bf16_t* VT; bf16_t* GT; bf16_t* HID; int Mc;
    __device__ __forceinline__ void operator()(const f32x4 (&acc)[2][2][4][2], const Unit& u, int wr, int wc, int fr, int fq) const {
        const int row0 = u.pm * BM + wr * 64 + fr; const int cl = wc * 32 + 8 * fq; const int pn = u.pn;
        int kind, dt;
        if (mode == 1) { kind = 3; dt = pn; }
        else if (pn < 12) { const int s = pn >> 1, o = pn & 1;
            if (s == 2) { kind = 1; dt = o; } else if (s == 5) { kind = 1; dt = 2 + o; } else { kind = 0; dt = (s < 2 ? s * 2 : (s - 1) * 2) + o; } }
        else if (pn < 24) { kind = 0; dt = 8 + (pn - 12); }
        else if (pn < 30) { kind = 1; dt = 4 + (pn - 24); }
        else { kind = 2; dt = pn - 30; }
        if (kind == 1) {
            const int ld = dt < 6 ? 0 : (dt < 8 ? 2 : 4);
#pragma unroll
            for (int ai = 0; ai < 2; ++ai)
#pragma unroll
                for (int m = 0; m < 4; ++m) {
                    const int t = row0 + ai * HALF + m * 16; const int s = t & 4095;
                    const int pt = (t & ~4095) + (s & ((1 << ld) - 1)) * (4096 >> ld) + (s >> ld);
#pragma unroll
                    for (int bj = 0; bj < 2; ++bj)
#pragma unroll
                        for (int n = 0; n < 2; ++n) { const f32x4 v = acc[ai][bj][m][n];
                            bf16_t* p = VT + (size_t)(dt * 256 + bj * HALF + cl + 4 * n) * Mc + pt;
                            const unsigned w0 = cvt_pk_bf16(v[0], v[1]), w1 = cvt_pk_bf16(v[2], v[3]);
                            p[0] = (bf16_t)(w0 & 0xffffu); p[(size_t)Mc] = (bf16_t)(w0 >> 16); p[2 * (size_t)Mc] = (bf16_t)(w1 & 0xffffu); p[3 * (size_t)Mc] = (bf16_t)(w1 >> 16); }
                }
            return;
        }
        bf16_t* base; int ldc;
        if (kind == 0) { base = QK; ldc = 5120; } else if (kind == 2) { base = GT; ldc = 3072; } else { base = HID; ldc = 4096; }
        base += dt * 256 + cl;
#pragma unroll
        for (int ai = 0; ai < 2; ++ai)
#pragma unroll
            for (int m = 0; m < 4; ++m) { bf16_t* rowp = base + (size_t)(row0 + ai * HALF + m * 16) * ldc;
#pragma unroll
                for (int bj = 0; bj < 2; ++bj) { f32x4 v0 = acc[ai][bj][m][0], v1 = acc[ai][bj][m][1];
                    if (kind == 2) {
#pragma unroll
                        for (int e = 0; e < 4; ++e) { v0[e] = fsigmoid(v0[e]); v1[e] = fsigmoid(v1[e]); } }
                    else if (kind == 3) {
#pragma unroll
                        for (int e = 0; e < 4; ++e) { const float a = fmaxf(v0[e], 0.f), b = fmaxf(v1[e], 0.f); v0[e] = a * a; v1[e] = b * b; } }
                    u32x4 w; w.x = cvt_pk_bf16(v0[0], v0[1]); w.y = cvt_pk_bf16(v0[2], v0[3]); w.z = cvt_pk_bf16(v1[0], v1[1]); w.w = cvt_pk_bf16(v1[2], v1[3]);
                    *(u32x4*)(rowp + bj * HALF) = w; } }
    }
};

struct EpiF {
    static constexpr bool PERM = false, AFTER_DRAIN = false;
    int mode; float* F; const float* X; float* Y; const bf16_t* GT; bf16_t* OB; int gofs; int rowoff; float alpha;
    __device__ __forceinline__ void operator()(const f32x4 (&acc)[2][2][4][2], const Unit& u, int wr, int wc, int fr, int fq) const {
        const int row0 = u.pm * BM + wr * 64 + fr; const int col0 = u.pn * BM + wc * 32 + 4 * fq;
#pragma unroll
        for (int ai = 0; ai < 2; ++ai)
#pragma unroll
            for (int m = 0; m < 4; ++m) { const int row = row0 + ai * HALF + m * 16;
#pragma unroll
                for (int bj = 0; bj < 2; ++bj)
#pragma unroll
                    for (int n = 0; n < 2; ++n) { const int col = col0 + bj * HALF + n * 16; const f32x4 v = acc[ai][bj][m][n];
                        const size_t o = (size_t)row * 1024 + col;
                        if (mode <= 2) {
                            const u32x2 gw = *(const u32x2*)(GT + (size_t)row * 3072 + gofs + col);
                            f32x4 g; g[0] = __uint_as_float(gw.x << 16); g[1] = __uint_as_float(gw.x & 0xffff0000u); g[2] = __uint_as_float(gw.y << 16); g[3] = __uint_as_float(gw.y & 0xffff0000u);
                            f32x4 r = g * v;
                            if (mode >= 1) r += *(const f32x4*)(F + o);
                            if (mode <= 1) *(f32x4*)(F + o) = r;
                            else { u32x2 w; w.x = cvt_pk_bf16(r[0], r[1]); w.y = cvt_pk_bf16(r[2], r[3]); *(u32x2*)(OB + o) = w; }
                        } else if (mode == 3) {
                            const size_t og = o + (size_t)rowoff * 1024;
                            *(f32x4*)(Y + og) = *(const f32x4*)(X + og) * alpha + v;
                        } else if (mode == 4) {
                            f32x4 r; r[0] = fsigmoid(v[0]); r[1] = fsigmoid(v[1]); r[2] = fsigmoid(v[2]); r[3] = fsigmoid(v[3]);
                            *(f32x4*)(F + o) = r;
                        } else if (mode == 5) {
                            *(f32x4*)(Y + o) = *(const f32x4*)(Y + o) * alpha + *(const f32x4*)(F + o) * v;
                        } else {
                            *(f32x4*)(Y + o) = *(const f32x4*)(Y + o) + v;
                        }
                    }
                asm volatile("" ::: "memory"); }
    }
};
template <class Epi, class Sched, bool ALIGN_EPI = false, bool SP2 = false>
__device__ __forceinline__ void gemm_phase(PG8_LAS unsigned char* lds, const Gemm g, const Sched& S, const Epi& E, const int tid_in) {
    const int tid = tid_in, wid = __builtin_amdgcn_readfirstlane(tid >> 6), lane = tid & 63, wr = wid >> 2, wc = wid & 3, fr = lane & 15, fq = lane >> 4;
    const int K = g.K, nt = K / BK;
    unsigned voffA[2], voffB[2];
#pragma unroll
    for (int i = 0; i < 2; ++i) { int R, C; stage_rc(tid * 16 + i * 8192, R, C); const int Rb = Epi::PERM ? ((R & ~31) + perm32(R & 31)) : R;
        voffA[i] = (unsigned)(R * K + C) * 2u; voffB[i] = (unsigned)(Rb * K + C) * 2u; }
    const size_t kstep = (size_t)(BK * 2);
    const size_t hstep = (size_t)HALF * K * 2;
    const size_t tstep = 2 * hstep;
    const unsigned ldsw = (unsigned)wid * 1024u;
    const int aoff = lds_byte(wr * 64 + fr, fq * 8), boff = lds_byte(wc * 32 + fr, fq * 8);
#define PG8_SA(b, h) (((b) * 2 + (h)) * HTB)
#define PG8_SB(b, h) ((4 + (b) * 2 + (h)) * HTB)
#define PG8_STAGE(bufoff, gbase, voff) do { _Pragma("unroll") for (int _i = 0; _i < 2; ++_i) \
        __builtin_amdgcn_global_load_lds((const unsigned*)((const char*)(gbase) + (voff)[_i]), (PG8_LAS unsigned*)(lds + (bufoff) + ldsw + _i * 8192), 16, 0, 0); } while (0)
#define PG8_LDA(dst, b, h) do { _Pragma("unroll") for (int m = 0; m < 4; ++m) _Pragma("unroll") for (int k = 0; k < 2; ++k) dst[m][k] = *(const PG8_LAS bf16x8*)(lds + PG8_SA(b, h) + aoff + m * 2048 + k * 1024); } while (0)
#define PG8_LDB(dst, b, h) do { _Pragma("unroll") for (int n = 0; n < 2; ++n) _Pragma("unroll") for (int k = 0; k < 2; ++k) dst[n][k] = *(const PG8_LAS bf16x8*)(lds + PG8_SB(b, h) + boff + n * 2048 + k * 1024); } while (0)
#define PG8_MMA(ai, bj, At, Bt) do { __builtin_amdgcn_s_setprio(1); _Pragma("unroll") for (int m = 0; m < 4; ++m) _Pragma("unroll") for (int n = 0; n < 2; ++n) _Pragma("unroll") for (int k = 0; k < 2; ++k) \
        acc[ai][bj][m][n] = __builtin_amdgcn_mfma_f32_16x16x32_bf16(Bt[n][k], At[m][k], acc[ai][bj][m][n], 0, 0, 0); __builtin_amdgcn_s_setprio(0); } while (0)
#define PG8_WAIT_V(n) asm volatile("s_waitcnt vmcnt(" #n ")" ::: "memory")
#define PG8_WAIT_L(n) asm volatile("s_waitcnt lgkmcnt(" #n ")" ::: "memory")
#define PG8_BAR __builtin_amdgcn_s_barrier()
#define PG8_SCHED __builtin_amdgcn_sched_barrier(0)
    Unit cur, nxt; int ui = 0;
    if (!S.next(0, cur)) return;
    f32x4 acc[2][2][4][2];
#pragma unroll
    for (int a = 0; a < 2; ++a)
#pragma unroll
        for (int b = 0; b < 2; ++b)
#pragma unroll
            for (int m = 0; m < 4; ++m)
#pragma unroll
                for (int n = 0; n < 2; ++n) acc[a][b][m][n] = (f32x4){0.f, 0.f, 0.f, 0.f};
    bf16x8 At[4][2], B0[2][2], B1[2][2];
    const char* cA = (const char*)g.A + (size_t)cur.pm * tstep; const char* cB = (const char*)g.Bt + (size_t)cur.pn * tstep;
    S.a_ready(cur);
    if constexpr (SP2) {
        PG8_STAGE(PG8_SB(0, 0), cB, voffB); PG8_STAGE(PG8_SB(0, 1), cB + hstep, voffB); PG8_STAGE(PG8_SA(0, 0), cA, voffA); PG8_STAGE(PG8_SA(0, 1), cA + hstep, voffA);
        if (wr == 1) PG8_BAR;
        PG8_WAIT_V(2); PG8_BAR;
        PG8_STAGE(PG8_SB(1, 0), cB + kstep, voffB); PG8_STAGE(PG8_SA(1, 0), cA + kstep, voffA); PG8_STAGE(PG8_SB(1, 1), cB + hstep + kstep, voffB);
        PG8_WAIT_V(6); PG8_BAR;
    } else {
        PG8_STAGE(PG8_SB(0, 0), cB, voffB); PG8_STAGE(PG8_SA(0, 0), cA, voffA); PG8_STAGE(PG8_SB(0, 1), cB + hstep, voffB); PG8_STAGE(PG8_SA(0, 1), cA + hstep, voffA);
        if (wr == 1) PG8_BAR;
        PG8_WAIT_V(4); PG8_BAR;
        PG8_STAGE(PG8_SB(1, 0), cB + kstep, voffB); PG8_STAGE(PG8_SA(1, 0), cA + kstep, voffA); PG8_STAGE(PG8_SB(1, 1), cB + hstep + kstep, voffB);
        PG8_WAIT_V(6); PG8_BAR;
    }
    for (;;) {
        const bool has_next = S.next(ui + 1, nxt);
        const char* nA = has_next ? (const char*)g.A + (size_t)nxt.pm * tstep : cA; const char* nB = has_next ? (const char*)g.Bt + (size_t)nxt.pn * tstep : cB;
        for (int t = 0; t < nt; t += 2) {
            const bool last = (t == nt - 2);
            const char* a1 = cA + (size_t)(t + 1) * kstep;
            const char* a2 = last ? nA : cA + (size_t)(t + 2) * kstep; const char* b2 = last ? nB : cB + (size_t)(t + 2) * kstep;
            const char* a3 = a2 + kstep; const char* b3 = b2 + kstep;
            if (last && has_next) S.a_ready(nxt);
            if constexpr (SP2) {
            PG8_LDB(B0, 0, 0); PG8_LDB(B1, 0, 1); PG8_SCHED; PG8_LDA(At, 0, 0); PG8_STAGE(PG8_SA(1, 1), a1 + hstep, voffA);
            PG8_WAIT_V(8); PG8_WAIT_L(0); PG8_BAR; PG8_MMA(0, 0, At, B0); PG8_MMA(0, 1, At, B1); PG8_BAR; PG8_SCHED;
            PG8_LDA(At, 0, 1); PG8_STAGE(PG8_SB(0, 0), b2, voffB); PG8_STAGE(PG8_SB(0, 1), b2 + hstep, voffB); PG8_STAGE(PG8_SA(0, 0), a2, voffA);
            PG8_WAIT_V(8); PG8_WAIT_L(0); PG8_BAR; PG8_MMA(1, 0, At, B0); PG8_MMA(1, 1, At, B1); PG8_BAR; PG8_SCHED;
            PG8_LDB(B0, 1, 0); PG8_LDB(B1, 1, 1); PG8_SCHED; PG8_LDA(At, 1, 0); PG8_STAGE(PG8_SA(0, 1), a2 + hstep, voffA);
            PG8_WAIT_V(8); PG8_WAIT_L(0); PG8_BAR; PG8_MMA(0, 0, At, B0); PG8_MMA(0, 1, At, B1); PG8_BAR; PG8_SCHED;
            PG8_LDA(At, 1, 1); PG8_STAGE(PG8_SB(1, 0), b3, voffB); PG8_STAGE(PG8_SB(1, 1), b3 + hstep, voffB); PG8_STAGE(PG8_SA(1, 0), a3, voffA);
            PG8_WAIT_V(8); PG8_WAIT_L(0); PG8_BAR; PG8_MMA(1, 0, At, B0); PG8_MMA(1, 1, At, B1); PG8_BAR; PG8_SCHED;
            } else {
            PG8_LDB(B0, 0, 0); PG8_SCHED; PG8_LDA(At, 0, 0); PG8_STAGE(PG8_SA(1, 1), a1 + hstep, voffA);
            PG8_WAIT_L(8); PG8_BAR; PG8_WAIT_L(0); PG8_MMA(0, 0, At, B0); PG8_BAR; PG8_SCHED;
            PG8_LDB(B1, 0, 1); PG8_STAGE(PG8_SB(0, 0), b2, voffB);
            PG8_BAR; PG8_WAIT_L(0); PG8_MMA(0, 1, At, B1); PG8_BAR;
            PG8_LDA(At, 0, 1); PG8_STAGE(PG8_SA(0, 0), a2, voffA);
            PG8_BAR; PG8_WAIT_L(0); PG8_MMA(1, 0, At, B0); PG8_BAR; PG8_SCHED;
            PG8_STAGE(PG8_SB(0, 1), b2 + hstep, voffB);
            PG8_WAIT_V(6); PG8_BAR; PG8_MMA(1, 1, At, B1); PG8_BAR;
            PG8_LDB(B0, 1, 0); PG8_SCHED; PG8_LDA(At, 1, 0); PG8_STAGE(PG8_SA(0, 1), a2 + hstep, voffA);
            PG8_WAIT_L(8); PG8_BAR; PG8_WAIT_L(0); PG8_MMA(0, 0, At, B0); PG8_BAR; PG8_SCHED;
            PG8_LDB(B1, 1, 1); PG8_STAGE(PG8_SB(1, 0), b3, voffB);
            PG8_BAR; PG8_WAIT_L(0); PG8_MMA(0, 1, At, B1); PG8_BAR;
            PG8_LDA(At, 1, 1); PG8_STAGE(PG8_SA(1, 0), a3, voffA);
            PG8_BAR; PG8_WAIT_L(0); PG8_MMA(1, 0, At, B0); PG8_BAR; PG8_SCHED;
            PG8_STAGE(PG8_SB(1, 1), b3 + hstep, voffB);
            PG8_WAIT_V(6); PG8_BAR; PG8_MMA(1, 1, At, B1); PG8_BAR;
            }
        }
        if constexpr (ALIGN_EPI) { if (wr == 0) PG8_BAR; }
        if constexpr (!Epi::AFTER_DRAIN) { E(acc, cur, wr, wc, fr, fq); S.done(cur); }
        if (!has_next) break;
#pragma unroll
        for (int a = 0; a < 2; ++a)
#pragma unroll
            for (int b = 0; b < 2; ++b)
#pragma unroll
                for (int m = 0; m < 4; ++m)
#pragma unroll
                    for (int n = 0; n < 2; ++n) acc[a][b][m][n] = (f32x4){0.f, 0.f, 0.f, 0.f};
        cur = nxt; cA = nA; cB = nB; ++ui;
        if constexpr (ALIGN_EPI) { if (wr == 1) PG8_BAR; }
    }
    PG8_WAIT_V(0);
    if constexpr (!ALIGN_EPI) { if (wr == 0) PG8_BAR; }
    PG8_BAR;
    if constexpr (Epi::AFTER_DRAIN) { E.fused(acc, cur, wr, wc, fr, fq, lds, wid, lane); S.done(cur); }
#undef PG8_SA
#undef PG8_SB
#undef PG8_STAGE
#undef PG8_LDA
#undef PG8_LDB
#undef PG8_MMA
#undef PG8_WAIT_V
#undef PG8_WAIT_L
#undef PG8_BAR
#undef PG8_SCHED
}
}
namespace att {
#define LAS __attribute__((address_space(3)))
typedef unsigned short bf16_t;
typedef short bf16x8 __attribute__((ext_vector_type(8)));
typedef float f32x16 __attribute__((ext_vector_type(16)));
typedef float f32x4 __attribute__((ext_vector_type(4)));
typedef unsigned u32x4 __attribute__((ext_vector_type(4)));
typedef unsigned u32x2 __attribute__((ext_vector_type(2)));
constexpr float LOG2E = 1.4426950408889634f;
constexpr float NEG = -1.0e30f;
constexpr int LDQK = 5120;
__device__ __forceinline__ f32x16 mfma(bf16x8 a, bf16x8 b, f32x16 c) { return __builtin_amdgcn_mfma_f32_32x32x16_bf16(a, b, c, 0, 0, 0); }
__device__ __forceinline__ bf16x8 ld16(const bf16_t* p) { return *(const bf16x8*)p; }
__device__ __forceinline__ unsigned cvtpk(float lo, float hi) { typedef float f2 __attribute__((ext_vector_type(2))); typedef __bf16 b2 __attribute__((ext_vector_type(2))); f2 v = {lo, hi}; b2 b = __builtin_convertvector(v, b2); return __builtin_bit_cast(unsigned, b); }
__device__ __forceinline__ bf16x8 pack8(float a0, float a1, float a2, float a3, float a4, float a5, float a6, float a7) {
    u32x4 w; w.x = cvtpk(a0, a1); w.y = cvtpk(a2, a3); w.z = cvtpk(a4, a5); w.w = cvtpk(a6, a7); return __builtin_bit_cast(bf16x8, w); }
__device__ __forceinline__ float ex2(float x) { return __builtin_amdgcn_exp2f(x); }
__device__ __forceinline__ float lg2(float x) { return __builtin_amdgcn_logf(x); }
__device__ __forceinline__ int kperm(int m) { return ((m >> 4) << 4) | (((m >> 2) & 1) << 3) | (((m >> 3) & 1) << 2) | (m & 3); }
__device__ __forceinline__ int rel_bucket(int d) { if (d < 16) return d; const float lr = logf((float)d / 16.0f) / 4.852030263919617f; const int large = 16 + (int)(lr * 16.0f); return large < 31 ? large : 31; }
__device__ __forceinline__ float wsum(float v) {
#pragma unroll
    for (int o = 1; o < 64; o <<= 1) v += __shfl_xor(v, o);
    return v; }
#define KL(r, hi) (16 * ((r) >> 3) + 8 * (hi) + ((r) & 7))

constexpr int KROW = 272, VROW = 144, KBUF = 64 * KROW, VBUF = 128 * VROW;
__device__ __forceinline__ void attnA_unit(LAS unsigned char* lds, const bf16_t* QK, const bf16_t* VT, bf16_t* ODA, int Mc, int b, int h, int p,
                                           const float* lam4, const float* normg, const float* relb, float lam_init, int tid, int wave, int lane) {
    LAS float* tbl = (LAS float*)lds;
    LAS unsigned char* Kb = lds + 16384; LAS unsigned char* Vb = lds + 16384 + 2 * KBUF;
    __syncthreads();
    for (int d = tid; d < 4096; d += 512) tbl[d] = relb[rel_bucket(d) * 16 + h] * LOG2E;
    const float s0 = wsum(lam4[lane] * lam4[64 + lane]), s1 = wsum(lam4[128 + lane] * lam4[192 + lane]);
    const float lam = expf(s0) - expf(s1) + lam_init;
    const int hi = lane >> 5, ql = lane & 31;
    const int sb = (wave < 4) ? (4 * p + wave) : (4 * (31 - p) + 3 - (wave - 4));
    const int qpos = sb * 32 + ql;
    const size_t tokbase = (size_t)b * 4096;
    const float SC = 0.125f * LOG2E;
    const int NT = 64 - 2 * p;
    const bf16_t* qrow = QK + (tokbase + qpos) * LDQK + h * 128 + hi * 8;
    bf16x8 qf[2][4];
#pragma unroll
    for (int mp = 0; mp < 2; ++mp)
#pragma unroll
        for (int st = 0; st < 4; ++st) qf[mp][st] = ld16(qrow + mp * 64 + st * 16);
    const bf16_t* kg = QK + (tokbase + (tid >> 4)) * LDQK + 512 + h * 128 + (tid & 15) * 8;
    const int kl_off = (tid >> 4) * KROW + (tid & 15) * 16;
    const bf16_t* vg = VT + (size_t)(h * 128 + (tid >> 3)) * Mc + tokbase + (tid & 7) * 8;
    const int vl_off = (tid >> 3) * VROW + (tid & 7) * 16;
    const int ka_off = kperm(ql) * KROW + hi * 16, va_off = ql * VROW + hi * 16;
    bf16x8 kp0, kp1, vp0, vp1;
    kp0 = ld16(kg); kp1 = ld16(kg + (size_t)32 * LDQK);
    *(LAS bf16x8*)(Kb + kl_off) = kp0; *(LAS bf16x8*)(Kb + kl_off + 32 * KROW) = kp1;
    __syncthreads();
    float mx[2] = {NEG, NEG}, sm[2] = {0.f, 0.f};
    for (int jt = 0; jt < NT; ++jt) {
        const LAS unsigned char* kb = Kb + (jt & 1) * KBUF;
        const bool more = jt + 1 < NT;
        if (more) { const bf16_t* g2 = kg + (size_t)(64 * (jt + 1)) * LDQK; kp0 = ld16(g2); kp1 = ld16(g2 + (size_t)32 * LDQK); }
#pragma unroll
        for (int hf = 0; hf < 2; ++hf) {
            const int kt = 2 * jt + hf;
            if (kt <= sb) {
                const LAS unsigned char* kr = kb + ka_off + hf * 32 * KROW;
                const int dbase = qpos - kt * 32 - 8 * hi;
                float bias[16];
#pragma unroll
                for (int r = 0; r < 16; ++r) { const int d = dbase - (r & 7) - 16 * (r >> 3); bias[r] = tbl[d > 0 ? d : 0]; }
#pragma unroll
                for (int mp = 0; mp < 2; ++mp) {
                    f32x16 s = {0.f, 0.f, 0.f, 0.f, 0.f, 0.f, 0.f, 0.f, 0.f, 0.f, 0.f, 0.f, 0.f, 0.f, 0.f, 0.f};
#pragma unroll
                    for (int st = 0; st < 4; ++st) s = mfma(*(const LAS bf16x8*)(kr + mp * 128 + st * 32), qf[mp][st], s);
                    float mt = NEG;
#pragma unroll
                    for (int r = 0; r < 16; ++r) { const int d = dbase - (r & 7) - 16 * (r >> 3); const float v = d >= 0 ? s[r] * SC + bias[r] : NEG; s[r] = v; mt = fmaxf(mt, v); }
                    const float mn = fmaxf(mx[mp], mt); float a = 0.f;
#pragma unroll
                    for (int r = 0; r < 16; ++r) a += ex2(s[r] - mn);
                    sm[mp] = sm[mp] * ex2(mx[mp] - mn) + a; mx[mp] = mn;
                }
            }
        }
        if (more) { LAS unsigned char* kn = Kb + ((jt + 1) & 1) * KBUF; *(LAS bf16x8*)(kn + kl_off) = kp0; *(LAS bf16x8*)(kn + kl_off + 32 * KROW) = kp1; }
        __syncthreads();
    }
    float Mf[2], iL[2];
#pragma unroll
    for (int mp = 0; mp < 2; ++mp) { const float mo = __shfl_xor(mx[mp], 32), so = __shfl_xor(sm[mp], 32); const float M = fmaxf(mx[mp], mo);
        const float L = sm[mp] * ex2(mx[mp] - M) + so * ex2(mo - M); Mf[mp] = M; iL[mp] = 1.0f / L; }
    const float c0 = iL[0], c1 = lam * iL[1];
    f32x16 O[4];
#pragma unroll
    for (int k = 0; k < 4; ++k) O[k] = (f32x16){0.f, 0.f, 0.f, 0.f, 0.f, 0.f, 0.f, 0.f, 0.f, 0.f, 0.f, 0.f, 0.f, 0.f, 0.f, 0.f};
    kp0 = ld16(kg); kp1 = ld16(kg + (size_t)32 * LDQK); vp0 = ld16(vg); vp1 = ld16(vg + (size_t)64 * Mc);
    *(LAS bf16x8*)(Kb + kl_off) = kp0; *(LAS bf16x8*)(Kb + kl_off + 32 * KROW) = kp1;
    *(LAS bf16x8*)(Vb + vl_off) = vp0; *(LAS bf16x8*)(Vb + vl_off + 64 * VROW) = vp1;
    __syncthreads();
    for (int jt = 0; jt < NT; ++jt) {
        const LAS unsigned char* kb = Kb + (jt & 1) * KBUF; const LAS unsigned char* vb = Vb + (jt & 1) * VBUF;
        const bool more = jt + 1 < NT;
        if (more) { const bf16_t* g2 = kg + (size_t)(64 * (jt + 1)) * LDQK; kp0 = ld16(g2); kp1 = ld16(g2 + (size_t)32 * LDQK);
                    const bf16_t* g3 = vg + 64 * (jt + 1); vp0 = ld16(g3); vp1 = ld16(g3 + (size_t)64 * Mc); }
#pragma unroll
        for (int hf = 0; hf < 2; ++hf) {
            const int kt = 2 * jt + hf;
            if (kt <= sb) {
                const LAS unsigned char* kr = kb + ka_off + hf * 32 * KROW;
                const int dbase = qpos - kt * 32 - 8 * hi;
                f32x16 s0v = {0.f, 0.f, 0.f, 0.f, 0.f, 0.f, 0.f, 0.f, 0.f, 0.f, 0.f, 0.f, 0.f, 0.f, 0.f, 0.f}, s1v = s0v;
#pragma unroll
                for (int st = 0; st < 4; ++st) { s0v = mfma(*(const LAS bf16x8*)(kr + st * 32), qf[0][st], s0v); s1v = mfma(*(const LAS bf16x8*)(kr + 128 + st * 32), qf[1][st], s1v); }
                float w[16];
#pragma unroll
                for (int r = 0; r < 16; ++r) { const int d = dbase - (r & 7) - 16 * (r >> 3); const float bb = tbl[d > 0 ? d : 0];
                    const float e0 = ex2(s0v[r] * SC + bb - Mf[0]), e1 = ex2(s1v[r] * SC + bb - Mf[1]);
                    w[r] = d >= 0 ? (e0 * c0 - e1 * c1) : 0.f; }
                const bf16x8 pb0 = pack8(w[0], w[1], w[2], w[3], w[4], w[5], w[6], w[7]), pb1 = pack8(w[8], w[9], w[10], w[11], w[12], w[13], w[14], w[15]);
                const LAS unsigned char* vr = vb + va_off + hf * 64;
#pragma unroll
                for (int k = 0; k < 4; ++k) { O[k] = mfma(*(const LAS bf16x8*)(vr + k * 32 * VROW), pb0, O[k]); O[k] = mfma(*(const LAS bf16x8*)(vr + k * 32 * VROW + 32), pb1, O[k]); }
            }
        }
        if (more) { LAS unsigned char* kn = Kb + ((jt + 1) & 1) * KBUF; LAS unsigned char* vn = Vb + ((jt + 1) & 1) * VBUF;
            *(LAS bf16x8*)(kn + kl_off) = kp0; *(LAS bf16x8*)(kn + kl_off + 32 * KROW) = kp1; *(LAS bf16x8*)(vn + vl_off) = vp0; *(LAS bf16x8*)(vn + vl_off + 64 * VROW) = vp1; }
        __syncthreads();
    }
    float ss = 0.f;
#pragma unroll
    for (int k = 0; k < 4; ++k)
#pragma unroll
        for (int r = 0; r < 16; ++r) ss += O[k][r] * O[k][r];
    ss += __shfl_xor(ss, 32);
    const float rs = (1.0f / sqrtf(ss * (1.0f / 128.0f) + 1e-5f)) * (1.0f - lam_init);
    bf16_t* orow = ODA + (tokbase + qpos) * 512 + h * 128 + 4 * hi;
#pragma unroll
    for (int k = 0; k < 4; ++k)
#pragma unroll
        for (int rr = 0; rr < 4; ++rr) { const int dv = 32 * k + 8 * rr; const f32x4 g = *(const f32x4*)(normg + dv + 4 * hi);
            u32x2 o; o.x = cvtpk(O[k][4 * rr] * rs * g[0], O[k][4 * rr + 1] * rs * g[1]); o.y = cvtpk(O[k][4 * rr + 2] * rs * g[2], O[k][4 * rr + 3] * rs * g[3]);
            *(u32x2*)(orow + dv) = o; }
}

__device__ __forceinline__ void attnB_unit(const bf16_t* QK, const bf16_t* VT, bf16_t* OSB, int Mc, int b, int h, int qb, int wave, int lane) {
    const int hi = lane >> 5, ql = lane & 31;
    const int sb = qb * 8 + wave; const int qpos = sb * 32 + ql;
    const size_t tokbase = (size_t)b * 4096;
    const float SC = 0.125f * LOG2E;
    const bf16_t* qrow = QK + (tokbase + qpos) * LDQK + 1024 + h * 64 + hi * 8;
    bf16x8 qf[4];
#pragma unroll
    for (int st = 0; st < 4; ++st) qf[st] = ld16(qrow + st * 16);
    const bf16_t* kbase = QK + (tokbase + kperm(ql)) * LDQK + 1536 + h * 64 + hi * 8;
    const bf16_t* vbase = VT + (size_t)(512 + h * 64 + ql) * Mc + tokbase + 8 * hi;
    f32x16 O[2];
#pragma unroll
    for (int k = 0; k < 2; ++k) O[k] = (f32x16){0.f, 0.f, 0.f, 0.f, 0.f, 0.f, 0.f, 0.f, 0.f, 0.f, 0.f, 0.f, 0.f, 0.f, 0.f, 0.f};
    float carry = 0.f;
    for (int j = sb; j >= 0; --j) {
        const bf16_t* kr = kbase + (size_t)(j * 32) * LDQK;
        f32x16 s = {0.f, 0.f, 0.f, 0.f, 0.f, 0.f, 0.f, 0.f, 0.f, 0.f, 0.f, 0.f, 0.f, 0.f, 0.f, 0.f};
#pragma unroll
        for (int st = 0; st < 4; ++st) s = mfma(ld16(kr + st * 16), qf[st], s);
        const int dbase = qpos - j * 32 - 8 * hi;
        float lk[16], zz[16];
#pragma unroll
        for (int r = 0; r < 16; ++r) { const int d = dbase - (r & 7) - 16 * (r >> 3); const float z2 = s[r] * SC;
            const float sp = fmaxf(z2, 0.f) + lg2(1.0f + ex2(-fabsf(z2)));
            lk[r] = d > 0 ? -sp : 0.f; zz[r] = d > 0 ? z2 : NEG; }
        float sf[16]; float T0 = 0.f, T1 = 0.f;
#pragma unroll
        for (int r = 7; r >= 0; --r) { sf[r] = T0; T0 += lk[r]; }
#pragma unroll
        for (int r = 15; r >= 8; --r) { sf[r] = T1; T1 += lk[r]; }
        const float P0 = __shfl_xor(T0, 32), P1 = __shfl_xor(T1, 32);
        const float add0 = carry + (hi == 0 ? (P0 + T1 + P1) : (P1 + T1));
        const float add1 = carry + (hi == 0 ? P1 : 0.f);
        float a[16];
#pragma unroll
        for (int r = 0; r < 16; ++r) a[r] = ex2(zz[r] + lk[r] + sf[r] + (r < 8 ? add0 : add1));
        const bf16x8 pb0 = pack8(a[0], a[1], a[2], a[3], a[4], a[5], a[6], a[7]), pb1 = pack8(a[8], a[9], a[10], a[11], a[12], a[13], a[14], a[15]);
        const bf16_t* vr = vbase + j * 32;
#pragma unroll
        for (int k = 0; k < 2; ++k) { O[k] = mfma(ld16(vr + (size_t)(k * 32) * Mc), pb0, O[k]); O[k] = mfma(ld16(vr + (size_t)(k * 32) * Mc + 16), pb1, O[k]); }
        carry += (T0 + T1) + (P0 + P1);
        if (__all(carry < -160.0f)) break;
    }
    bf16_t* orow = OSB + (tokbase + qpos) * 512 + h * 64 + 4 * hi;
#pragma unroll
    for (int k = 0; k < 2; ++k)
#pragma unroll
        for (int rr = 0; rr < 4; ++rr) { u32x2 o; o.x = cvtpk(O[k][4 * rr], O[k][4 * rr + 1]); o.y = cvtpk(O[k][4 * rr + 2], O[k][4 * rr + 3]); *(u32x2*)(orow + 32 * k + 8 * rr) = o; }
}

__device__ __forceinline__ void attnC_unit(LAS float* tblC, const bf16_t* QK, const bf16_t* VT, float* SCR, float* LSE, bf16_t* ODL, int Mc, int b, int hh, int R,
                                           const float* relb, int tid, int wave, int lane) {
    __syncthreads();
    for (int i = tid; i < 3 * 129; i += 512) { const int g = i / 129, j = i - g * 129; tblC[g * 132 + j] = relb[rel_bucket(j << (2 * g)) * 16 + 4 + g * 4 + hh] * LOG2E; }
    __syncthreads();
    const int hi = lane >> 5, ql = lane & 31;
    const size_t tokbase = (size_t)b * 4096;
    const float SC = 0.08838834764831845f * LOG2E;
#pragma unroll 1
    for (int g = 0; g < 3; ++g) {
        const int ld = 2 * g, nmb = 16 >> ld;
#pragma unroll 1
        for (int tt = 0; tt < 2; ++tt) {
            const int t = wave * 2 + tt; const int res = t / nmb, mb = t - res * nmb;
            const int m0 = R * (512 >> ld) + 32 * mb;
            const int token = ((m0 + ql) << ld) + res;
            const bf16_t* qrow = QK + (tokbase + token) * LDQK + 2048 + g * 512 + hh * 128 + hi * 8;
            bf16x8 qf[8];
#pragma unroll
            for (int st = 0; st < 8; ++st) qf[st] = ld16(qrow + st * 16);
            f32x16 S[5];
            float mt = NEG;
#pragma unroll
            for (int jt = 0; jt < 5; ++jt) {
                const int mt0 = m0 - 128 + 32 * jt;
                f32x16 s = {0.f, 0.f, 0.f, 0.f, 0.f, 0.f, 0.f, 0.f, 0.f, 0.f, 0.f, 0.f, 0.f, 0.f, 0.f, 0.f};
                if (mt0 >= 0) {
                    const int ktok = ((mt0 + kperm(ql)) << ld) + res;
                    const bf16_t* kr = QK + (tokbase + ktok) * LDQK + 3584 + g * 512 + hh * 128 + hi * 8;
#pragma unroll
                    for (int st = 0; st < 8; ++st) s = mfma(ld16(kr + st * 16), qf[st], s);
                }
#pragma unroll
                for (int r = 0; r < 16; ++r) { const int jd = 128 - 32 * jt + ql - KL(r, hi);
                    const bool ok = (mt0 >= 0) && (jd >= 0) && (jd <= 128);
                    const float v = ok ? s[r] * SC + tblC[g * 132 + (jd < 0 ? 0 : (jd > 128 ? 128 : jd))] : NEG; s[r] = v; mt = fmaxf(mt, v); }
                S[jt] = s;
                asm volatile("" ::: "memory");
            }
            const float M = fmaxf(mt, __shfl_xor(mt, 32));
            float L = 0.f;
#pragma unroll
            for (int jt = 0; jt < 5; ++jt)
#pragma unroll
                for (int r = 0; r < 16; ++r) { const float e = ex2(S[jt][r] - M); S[jt][r] = e; L += e; }
            L += __shfl_xor(L, 32);
            const float iL = 1.0f / L;
            f32x16 O[4];
#pragma unroll
            for (int k = 0; k < 4; ++k) O[k] = (f32x16){0.f, 0.f, 0.f, 0.f, 0.f, 0.f, 0.f, 0.f, 0.f, 0.f, 0.f, 0.f, 0.f, 0.f, 0.f, 0.f};
            const bf16_t* vbase = VT + (size_t)(1024 + g * 512 + hh * 128 + ql) * Mc + tokbase + res * (4096 >> ld) + 8 * hi;
#pragma unroll
            for (int jt = 0; jt < 5; ++jt) {
                const int mt0 = m0 - 128 + 32 * jt;
                if (mt0 >= 0) {
                    const bf16x8 pb0 = pack8(S[jt][0] * iL, S[jt][1] * iL, S[jt][2] * iL, S[jt][3] * iL, S[jt][4] * iL, S[jt][5] * iL, S[jt][6] * iL, S[jt][7] * iL);
                    const bf16x8 pb1 = pack8(S[jt][8] * iL, S[jt][9] * iL, S[jt][10] * iL, S[jt][11] * iL, S[jt][12] * iL, S[jt][13] * iL, S[jt][14] * iL, S[jt][15] * iL);
                    const bf16_t* vr = vbase + mt0;
#pragma unroll
                    for (int k = 0; k < 4; ++k) { O[k] = mfma(ld16(vr + (size_t)(k * 32) * Mc), pb0, O[k]); O[k] = mfma(ld16(vr + (size_t)(k * 32) * Mc + 16), pb1, O[k]); }
                }
                asm volatile("" ::: "memory");
            }
            float lse = M + lg2(L);
            float* srow = SCR + (tokbase + token) * 512 + hh * 128 + 4 * hi;
            float* lp = LSE + (tokbase + token) * 4 + hh;
            if (g > 0) {
                const float lo = *lp; const float mxl = fmaxf(lo, lse);
                const float ea = ex2(lo - mxl), eb = ex2(lse - mxl); const float inv = 1.0f / (ea + eb);
                const float wa = ea * inv, wb = eb * inv; lse = mxl + lg2(ea + eb);
#pragma unroll
                for (int k = 0; k < 4; ++k)
#pragma unroll
                    for (int rr = 0; rr < 4; ++rr) { const f32x4 old = *(const f32x4*)(srow + 32 * k + 8 * rr);
#pragma unroll
                        for (int e = 0; e < 4; ++e) O[k][4 * rr + e] = wa * old[e] + wb * O[k][4 * rr + e]; }
            }
            if (g < 2) {
#pragma unroll
                for (int k = 0; k < 4; ++k)
#pragma unroll
                    for (int rr = 0; rr < 4; ++rr) *(f32x4*)(srow + 32 * k + 8 * rr) = (f32x4){O[k][4 * rr], O[k][4 * rr + 1], O[k][4 * rr + 2], O[k][4 * rr + 3]};
                if (hi == 0) *lp = lse;
            } else {
                bf16_t* orow = ODL + (tokbase + token) * 512 + hh * 128 + 4 * hi;
#pragma unroll
                for (int k = 0; k < 4; ++k)
#pragma unroll
                    for (int rr = 0; rr < 4; ++rr) { u32x2 o; o.x = cvtpk(O[k][4 * rr], O[k][4 * rr + 1]); o.y = cvtpk(O[k][4 * rr + 2], O[k][4 * rr + 3]); *(u32x2*)(orow + 32 * k + 8 * rr) = o; }
            }
        }
        if (g < 2) __syncthreads();
    }
}
}
constexpr int MTOK = 32768, DM = 1024, DFF = 4096, NPROJ = 10752, MC = 16384, NLAYER = 4;
constexpr size_t MiB = 1u << 20;
constexpr size_t WS_WIN = 1 * MiB, WS_WBR = 22 * MiB, WS_WOUT = 25 * MiB, WS_WUP = 27 * MiB, WS_WDOWN = 35 * MiB, WS_WG = 43 * MiB, WS_WP = 45 * MiB;
constexpr size_t WS_PB = 46 * MiB, WS_XB = 62 * MiB, WS_QK = 126 * MiB, WS_VT = 286 * MiB, WS_GT = 366 * MiB, WS_HID = 126 * MiB;
constexpr size_t WS_ODA = 462 * MiB, WS_OSB = 478 * MiB, WS_ODL = 494 * MiB, WS_SCR = 510 * MiB, WS_LSE = 542 * MiB, WS_MF = 543 * MiB, WS_MRG = 607 * MiB, WS_TMP = 462 * MiB, WS_END = 639 * MiB;
constexpr int LDS_BYTES = 143360;
constexpr float ALPHA = 1.681792830507429f;
typedef unsigned short bf16;
typedef unsigned v4u __attribute__((ext_vector_type(4)));
typedef float f32x4 __attribute__((ext_vector_type(4)));
__device__ __forceinline__ unsigned pk2(float lo, float hi) { return pg8::cvt_pk_bf16(lo, hi); }
__device__ __forceinline__ float wave_sum(float v) {
#pragma unroll
    for (int o = 1; o < 64; o <<= 1) v += __shfl_xor(v, o);
    return v; }
__device__ __forceinline__ void transpose_item(const float* W, int K, int N, bf16* WT, LAS float* scr, int item, int lane) {
    const int nblk = N / 32, kb = item / nblk, nb = item - kb * nblk, k0 = 64 * kb, n0 = 32 * nb;
#pragma unroll 8
    for (int i = 0; i < 32; ++i) { const int kk = 2 * i + (lane >> 5); scr[kk * 33 + (lane & 31)] = W[(size_t)(k0 + kk) * N + n0 + (lane & 31)]; }
    asm volatile("s_waitcnt lgkmcnt(0)" ::: "memory");
    const int c = lane & 7;
#pragma unroll
    for (int j = 0; j < 4; ++j) { const int n = (lane >> 3) + 8 * j; const LAS float* s = scr + (8 * c) * 33 + n;
        v4u o; o.x = pk2(s[0 * 33], s[1 * 33]); o.y = pk2(s[2 * 33], s[3 * 33]); o.z = pk2(s[4 * 33], s[5 * 33]); o.w = pk2(s[6 * 33], s[7 * 33]);
        *(v4u*)(WT + (size_t)(n0 + n) * K + k0 + 8 * c) = o; }
    asm volatile("s_waitcnt lgkmcnt(0)" ::: "memory");
}
struct Args { const float* in[18]; float* out; unsigned char* ws; };
constexpr int PTAB_OFF = 131072 + 4096;
__device__ __forceinline__ const float* ldptr(LAS unsigned char* lds, int i) {
    const unsigned long long v = ((LAS unsigned long long*)(lds + PTAB_OFF))[i];
    const unsigned lo = __builtin_amdgcn_readfirstlane((unsigned)v), hi = __builtin_amdgcn_readfirstlane((unsigned)(v >> 32));
    return (const float*)(((unsigned long long)hi << 32) | lo); }
__device__ __forceinline__ void convert_layer(unsigned char* ws, int layer, LAS unsigned char* lds, int gw, int NGW, int wave, int lane) {
    LAS float* scr = (LAS float*)(lds + wave * 16384);
    constexpr int I_IN = 16 * 336, I_BR = 8 * 32, I_O = 16 * 32, I_UP = 16 * 128, I_DN = 64 * 32, I_G = 16 * 32, I_P = 4 * 32;
    constexpr int NIT = I_IN + 3 * I_BR + I_O + I_UP + I_DN + I_G + I_P;
    for (int it = gw; it < NIT; it += NGW) {
        int r = it;
        if (r < I_IN) { transpose_item(ldptr(lds, 2) + (size_t)layer * 1024 * NPROJ, 1024, NPROJ, (bf16*)(ws + WS_WIN), scr, r, lane); continue; } r -= I_IN;
        if (r < 3 * I_BR) { const int br = r / I_BR; transpose_item(ldptr(lds, 5 + br) + (size_t)layer * 512 * 1024, 512, 1024, (bf16*)(ws + WS_WBR) + (size_t)br * 1024 * 512, scr, r - br * I_BR, lane); continue; } r -= 3 * I_BR;
        if (r < I_O) { transpose_item(ldptr(lds, 8) + (size_t)layer * 1024 * 1024, 1024, 1024, (bf16*)(ws + WS_WOUT), scr, r, lane); continue; } r -= I_O;
        if (r < I_UP) { transpose_item(ldptr(lds, 11) + (size_t)layer * 1024 * 4096, 1024, 4096, (bf16*)(ws + WS_WUP), scr, r, lane); continue; } r -= I_UP;
        if (r < I_DN) { transpose_item(ldptr(lds, 12) + (size_t)layer * 4096 * 1024, 4096, 1024, (bf16*)(ws + WS_WDOWN), scr, r, lane); continue; } r -= I_DN;
        if (r < I_G) { transpose_item(ldptr(lds, 13) + (size_t)layer * 1024 * 1024, 1024, 1024, (bf16*)(ws + WS_WG), scr, r, lane); continue; } r -= I_G;
        transpose_item(ldptr(lds, 14) + (size_t)layer * 256 * 1024, 256, 1024, (bf16*)(ws + WS_WP), scr, r, lane);
    }
    const float* ps = ldptr(lds, 1) + (size_t)layer * MTOK * 256; bf16* pd = (bf16*)(ws + WS_PB);
    for (size_t i = (size_t)gw * 64 + lane; i < (size_t)MTOK * 256 / 8; i += (size_t)NGW * 64) {
        const f32x4 u = *(const f32x4*)(ps + i * 8), v = *(const f32x4*)(ps + i * 8 + 4);
        v4u o; o.x = pk2(u[0], u[1]); o.y = pk2(u[2], u[3]); o.z = pk2(v[0], v[1]); o.w = pk2(v[2], v[3]); *(v4u*)(pd + i * 8) = o; }
}
__device__ __forceinline__ void ln_pass(float* Y, bf16* XB, const float* g, const float* bt, int gw, int NGW, int lane) {
    for (int m = gw; m < MTOK; m += NGW) {
        f32x4* yr = (f32x4*)(Y + (size_t)m * DM) + lane;
        f32x4 v[4]; float s = 0.f;
#pragma unroll
        for (int j = 0; j < 4; ++j) { v[j] = yr[64 * j]; s += (v[j][0] + v[j][1]) + (v[j][2] + v[j][3]); }
        const float mean = wave_sum(s) * (1.f / DM); float s2 = 0.f;
#pragma unroll
        for (int j = 0; j < 4; ++j) { v[j] = v[j] - mean; s2 += (v[j][0] * v[j][0] + v[j][1] * v[j][1]) + (v[j][2] * v[j][2] + v[j][3] * v[j][3]); }
        const float rstd = 1.f / sqrtf(wave_sum(s2) * (1.f / DM) + 1e-5f);
        unsigned long long* o8 = (unsigned long long*)(XB + (size_t)m * DM) + lane;
#pragma unroll
        for (int j = 0; j < 4; ++j) { const f32x4 gv = ((const f32x4*)g)[lane + 64 * j], bv = ((const f32x4*)bt)[lane + 64 * j];
            const f32x4 o = v[j] * rstd * gv + bv; yr[64 * j] = o;
            o8[64 * j] = (unsigned long long)pk2(o[0], o[1]) | ((unsigned long long)pk2(o[2], o[3]) << 32); }
    }
}

__global__ void __launch_bounds__(512, 2) mk_fwd(Args a) {
    extern __shared__ __attribute__((aligned(16))) unsigned char lds_raw[];
    LAS unsigned char* lds = (LAS unsigned char*)lds_raw;
    cg::grid_group grid = cg::this_grid();
    const int tid0 = threadIdx.x;
    const int G = gridDim.x, bid0 = blockIdx.x;
    const int NGW = G * 8;
    if (tid0 == 0) { LAS unsigned long long* pt = (LAS unsigned long long*)(lds + PTAB_OFF);
#pragma unroll
        for (int i = 0; i < 18; ++i) pt[i] = (unsigned long long)a.in[i]; }
    __syncthreads();
    { const int lane = tid0 & 63, wave = __builtin_amdgcn_readfirstlane(tid0 >> 6), gw = bid0 * 8 + wave; unsigned char* ws = a.ws; bf16* XB = (bf16*)(ws + WS_XB);
      convert_layer(ws, 0, lds, gw, NGW, wave, lane);
      const float* xs = ldptr(lds, 0);
      for (size_t i = (size_t)gw * 64 + lane; i < (size_t)MTOK * DM / 8; i += (size_t)NGW * 64) {
          const f32x4 u = *(const f32x4*)(xs + i * 8), v = *(const f32x4*)(xs + i * 8 + 4);
          v4u o; o.x = pk2(u[0], u[1]); o.y = pk2(u[2], u[3]); o.z = pk2(v[0], v[1]); o.w = pk2(v[2], v[3]); *(v4u*)(XB + i * 8) = o; } }
    grid.sync();
#ifdef PROBE_ATT2
    int rep = 0;
#endif
    for (int step = 0; step < NLAYER * 18; ++step) {
        const int layer = step / 18, s = step - layer * 18;
        int tid = tid0; asm volatile("" : "+v"(tid));
        const int lane = tid & 63, wave = __builtin_amdgcn_readfirstlane(tid >> 6);
        int bid = bid0; asm volatile("" : "+s"(bid));
        const int gw = bid * 8 + wave;
        unsigned char* ws = a.ws; asm volatile("" : "+s"(ws));
        float* outp = a.out; asm volatile("" : "+s"(outp));
        bf16* XB = (bf16*)(ws + WS_XB);
        int kind = 3; bool sync = true;
        pg8::Gemm g{nullptr, nullptr, 0, 0, 0};
        pg8::EpiB EB{0, (bf16*)(ws + WS_QK), (bf16*)(ws + WS_VT), (bf16*)(ws + WS_GT), (bf16*)(ws + WS_HID), MC};
        pg8::EpiF EF{0, nullptr, nullptr, outp, (const bf16*)(ws + WS_GT), (bf16*)(ws + WS_MRG), 0, 0, ALPHA};
        int chunk = 0;
        if (s < 12) {
            chunk = s / 6; const int k = s - chunk * 6;
            if (k == 0) { kind = 0; g = pg8::Gemm{XB + (size_t)chunk * MC * DM, (const bf16*)(ws + WS_WIN), MC, NPROJ, DM}; EB.mode = 0; }
            else if (k == 1) { kind = 2; }
            else if (k <= 4) { kind = 1; const int br = k - 2; sync = (k == 4);
                g = pg8::Gemm{(const bf16*)(ws + WS_ODA + (size_t)br * 16 * MiB), (const bf16*)(ws + WS_WBR) + (size_t)br * 1024 * 512, MC, DM, 512};
                EF.mode = br; EF.F = (float*)(ws + WS_MF); EF.gofs = br * 1024; }
            else { kind = 1; sync = (chunk == 1);
                g = pg8::Gemm{(const bf16*)(ws + WS_MRG), (const bf16*)(ws + WS_WOUT), MC, DM, DM};
                EF.mode = 3; EF.X = (layer == 0) ? ldptr(lds, 0) : outp; EF.rowoff = chunk * MC; }
        } else if (s == 12) { kind = 3; }
        else if (s == 13) { kind = 0; sync = false; g = pg8::Gemm{XB, (const bf16*)(ws + WS_WUP), MTOK, DFF, DM}; EB.mode = 1; }
        else if (s == 14) { kind = 1; sync = false; g = pg8::Gemm{XB, (const bf16*)(ws + WS_WG), MTOK, DM, DM}; EF.mode = 4; EF.F = (float*)(ws + WS_TMP); }
        else if (s == 15) { kind = 1; g = pg8::Gemm{(const bf16*)(ws + WS_PB), (const bf16*)(ws + WS_WP), MTOK, DM, 256}; EF.mode = 5; EF.F = (float*)(ws + WS_TMP); }
        else if (s == 16) { kind = 1; g = pg8::Gemm{(const bf16*)(ws + WS_HID), (const bf16*)(ws + WS_WDOWN), MTOK, DM, DFF}; EF.mode = 6; }
        else { kind = 4; }

#ifndef NO_GEMMB
        if (kind == 0) { pg8::StaticOrder S; S.init(g.M, g.N, G, bid); pg8::gemm_phase<pg8::EpiB, pg8::StaticOrder, true, true>(lds, g, S, EB, tid); }
#else
        if (0) {}
#endif
#ifndef NO_GEMMF
        else if (kind == 1) { pg8::StaticOrder S; S.init(g.M, g.N, G, bid); pg8::gemm_phase<pg8::EpiF, pg8::StaticOrder, true, true>(lds, g, S, EF, tid); }
#endif
#ifndef NO_ATT
        else if (kind == 2) {
            const bf16* QK = (const bf16*)(ws + WS_QK); const bf16* VT = (const bf16*)(ws + WS_VT);
            const float lam_init = 0.8f - 0.6f * expf(-0.3f * (float)layer);
#ifndef NO_A
            for (int u = bid; u < 256; u += G)
                att::attnA_unit(lds, QK, VT, (bf16*)(ws + WS_ODA), MC, u >> 6, (u >> 4) & 3, u & 15, ldptr(lds, 3) + layer * 256, ldptr(lds, 4) + layer * 128, ldptr(lds, 17), lam_init, tid, wave, lane);
#endif
#ifndef NO_C
            for (int u = bid; u < 128; u += G)
                att::attnC_unit((LAS float*)(lds + 126976), QK, VT, (float*)(ws + WS_SCR), (float*)(ws + WS_LSE), (bf16*)(ws + WS_ODL), MC, u >> 5, (u >> 3) & 3, u & 7, ldptr(lds, 17), tid, wave, lane);
#endif
#ifndef NO_B
            if (G > 128) { if (bid >= 128) for (int u = bid - 128; u < 512; u += G - 128) att::attnB_unit(QK, VT, (bf16*)(ws + WS_OSB), MC, u >> 7, (u >> 4) & 7, u & 15, wave, lane); }
            else for (int u = bid; u < 512; u += G) att::attnB_unit(QK, VT, (bf16*)(ws + WS_OSB), MC, u >> 7, (u >> 4) & 7, u & 15, wave, lane);
#endif
        }
#endif
        else if (kind == 3) { ln_pass(outp, XB, ldptr(lds, 9) + layer * DM, ldptr(lds, 10) + layer * DM, gw, NGW, lane); }
        else { ln_pass(outp, XB, ldptr(lds, 15) + layer * DM, ldptr(lds, 16) + layer * DM, gw, NGW, lane);
               if (layer + 1 < NLAYER) convert_layer(ws, layer + 1, lds, gw, NGW, wave, lane); }
#ifdef PROBE_ATT2
        if (kind == 2) { if (rep == 0) { rep = 1; --step; sync = false; } else rep = 0; }
#endif
        if (sync && step + 1 < NLAYER * 18) { grid.sync();
#ifdef PROBE_SYNC2
            grid.sync();
#endif
        }
    }
}

extern "C" void kernel_launch(void* const* d_in, const int* in_sizes, int n_in, void* d_out, int out_size, void* d_ws, size_t ws_size, hipStream_t stream) {
    static int grid = 0;
    if (grid == 0) {
        if (n_in != 18 || out_size != MTOK * DM || ws_size < WS_END) { fprintf(stderr, "kernel_launch: unexpected shapes (n_in %d out %d ws %zu)\n", n_in, out_size, ws_size); grid = -1; return; }
        int dev = 0, cus = 0, per_cu = 0;
        (void)hipGetDevice(&dev); (void)hipDeviceGetAttribute(&cus, hipDeviceAttributeMultiprocessorCount, dev);
        if (hipFuncSetAttribute((const void*)mk_fwd, hipFuncAttributeMaxDynamicSharedMemorySize, LDS_BYTES) != hipSuccess) { fprintf(stderr, "hipFuncSetAttribute failed\n"); grid = -1; return; }
        if (hipOccupancyMaxActiveBlocksPerMultiprocessor(&per_cu, (const void*)mk_fwd, 512, LDS_BYTES) != hipSuccess || per_cu < 1) { fprintf(stderr, "occupancy query says %d\n", per_cu); per_cu = 1; }
        (void)hipGetLastError();
        grid = cus;
    }
    if (grid < 0) return;
    Args a{};
    for (int i = 0; i < 18; ++i) a.in[i] = (const float*)d_in[i];
    a.out = (float*)d_out; a.ws = (unsigned char*)d_ws;
    void* args[] = {&a};
    hipError_t e = hipLaunchCooperativeKernel((const void*)mk_fwd, dim3(grid), dim3(512), args, LDS_BYTES, stream);
    if (e != hipSuccess) fprintf(stderr, "cooperative launch failed: %s (grid %d)\n", hipGetErrorString(e), grid);
}
```

```cpp
#include <hip/hip_runtime.h>
#include <hip/hip_cooperative_groups.h>
#include <cstdio>
#include <cstdint>
#include <cmath>
namespace cg = cooperative_groups;
namespace pg8 {
#define PG8_LAS __attribute__((address_space(3)))
typedef unsigned short bf16_t;
typedef short bf16x8 __attribute__((ext_vector_type(8)));
typedef float f32x4 __attribute__((ext_vector_type(4)));
typedef unsigned u32x4 __attribute__((ext_vector_type(4)));
constexpr int BM = 256, BK = 64, HALF = 128, HTB = HALF * BK * 2  , STAGE_BYTES = 8 * HTB, NXCD = 8, WGM = 8;

__host__ __device__ __forceinline__ int lds_byte(int r, int c) { const int st = (r >> 4) * 2 + (c >> 5), rr = r & 15, cc = c & 31, ob = rr * 64 + cc * 2; return st * 1024 + (ob ^ (((ob >> 9) & 1) << 5)); }
__host__ __device__ __forceinline__ void stage_rc(int b, int& R, int& C) { const int st = b / 1024, sb = b % 1024, swz = sb ^ (((sb >> 9) & 1) << 5); R = (st >> 1) * 16 + swz / 64; C = (st & 1) * 32 + (swz % 64) / 2; }
__host__ __device__ __forceinline__ int perm32(int rho) { const int n = rho >> 4, i = rho & 15; return 8 * (i >> 2) + 4 * n + (i & 3); }

struct Unit { int pm, pn; };
struct Gemm { const bf16_t* A; const bf16_t* Bt; int M, N, K; };

struct StaticOrder {
    int nM, nN, nwg, G, c;
    __host__ __device__ void init(int M, int N, int G_, int c_) { nM = M / BM; nN = N / BM; nwg = nM * nN; G = G_; c = c_; }
    __host__ __device__ bool next(int i, Unit& u) const {
        const long L = (long)i * G + c; if (L >= nwg) return false;
        int wgid = (int)L; { const int q = nwg / NXCD, r = nwg % NXCD, xcd = wgid % NXCD, off = wgid / NXCD; wgid = (xcd < r ? xcd * (q + 1) : r * (q + 1) + (xcd - r) * q) + off; }
        const int nig = WGM * nN, gid = wgid / nig, fm = gid * WGM, gsz = (nM - fm) < WGM ? (nM - fm) : WGM;
        u.pm = fm + ((wgid % nig) % gsz); u.pn = (wgid % nig) / gsz; return true;
    }
    __device__ __forceinline__ void a_ready(const Unit&) const {}
    __device__ __forceinline__ void done(const Unit&) const {}
};

__device__ __forceinline__ unsigned cvt_pk_bf16(float lo, float hi) { unsigned r; asm volatile("v_cvt_pk_bf16_f32 %0, %1, %2" : "=v"(r) : "v"(lo), "v"(hi)); return r; }
typedef float f32x2 __attribute__((ext_vector_type(2)));
typedef unsigned u32x2 __attribute__((ext_vector_type(2)));
__device__ __forceinline__ float fsigmoid(float x) { return __builtin_amdgcn_rcpf(1.0f + __expf(-x)); }

struct EpiB {
    static constexpr bool PERM = true, AFTER_DRAIN = false;
    int mode; bf16_t* QK; bf16_t* VT; bf16_t* GT; bf16_t* HID; int Mc;
    __device__ __forceinline__ void operator()(const f32x4 (&acc)[2][2][4][2], const Unit& u, int wr, int wc, int fr, int fq) const {
        const int row0 = u.pm * BM + wr * 64 + fr; const int cl = wc * 32 + 8 * fq; const int pn = u.pn;
        int kind, dt;
        if (mode == 1) { kind = 3; dt = pn; }
        else if (pn < 12) { const int s = pn >> 1, o = pn & 1;
            if (s == 2) { kind = 1; dt = o; } else if (s == 5) { kind = 1; dt = 2 + o; } else { kind = 0; dt = (s < 2 ? s * 2 : (s - 1) * 2) + o; } }
        else if (pn < 24) { kind = 0; dt = 8 + (pn - 12); }
        else if (pn < 30) { kind = 1; dt = 4 + (pn - 24); }
        else { kind = 2; dt = pn - 30; }
        if (kind == 1) {
            const int ld = dt < 6 ? 0 : (dt < 8 ? 2 : 4);
#pragma unroll
            for (int ai = 0; ai < 2; ++ai)
#pragma unroll
                for (int m = 0; m < 4; ++m) {
                    const int t = row0 + ai * HALF + m * 16; const int s = t & 4095;
                    const int pt = (t & ~4095) + (s & ((1 << ld) - 1)) * (4096 >> ld) + (s >> ld);
#pragma unroll
                    for (int bj = 0; bj < 2; ++bj)
#pragma unroll
                        for (int n = 0; n < 2; ++n) { const f32x4 v = acc[ai][bj][m][n];
                            bf16_t* p = VT + (size_t)(dt * 256 + bj * HALF + cl + 4 * n) * Mc + pt;
                            const unsigned w0 = cvt_pk_bf16(v[0], v[1]), w1 = cvt_pk_bf16(v[2], v[3]);
                            p[0] = (bf16_t)(w0 & 0xffffu); p[(size_t)Mc] = (bf16_t)(w0 >> 16); p[2 * (size_t)Mc] = (bf16_t)(w1 & 0xffffu); p[3 * (size_t)Mc] = (bf16_t)(w1 >> 16); }
                }
            return;
        }
        bf16_t* base; int ldc;
        if (kind == 0) { base = QK; ldc = 5120; } else if (kind == 2) { base = GT; ldc = 3072; } else { base = HID; ldc = 4096; }
        base += dt * 256 + cl;
#pragma unroll
        for (int ai = 0; ai < 2; ++ai)
#pragma unroll
            for (int m = 0; m < 4; ++m) { bf16_t* rowp = base + (size_t)(row0 + ai * HALF + m * 16) * ldc;
#pragma unroll
                for (int bj = 0; bj < 2; ++bj) { f32x4 v0 = acc[ai][bj][m][0], v1 = acc[ai][bj][m][1];
                    if (kind == 2) {
#pragma unroll
                        for (int e = 0; e < 4; ++e) { v0[e] = fsigmoid(v0[e]); v1[e] = fsigmoid(v1[e]); } }
                    else if (kind == 3) {
#pragma unroll
                        for (int e = 0; e < 4; ++e) { const float a = fmaxf(v0[e], 0.f), b = fmaxf(v1[e], 0.f); v0[e] = a * a; v1[e] = b * b; } }
                    u32x4 w; w.x = cvt_pk_bf16(v0[0], v0[1]); w.y = cvt_pk_bf16(v0[2], v0[3]); w.z = cvt_pk_bf16(v1[0], v1[1]); w.w = cvt_pk_bf16(v1[2], v1[3]);
                    *(u32x4*)(rowp + bj * HALF) = w; } }
    }
};

struct EpiF {
    static constexpr bool PERM = false, AFTER_DRAIN = false;
    int mode; float* F; const float* X; float* Y; const bf16_t* GT; bf16_t* OB; int gofs; int rowoff; float alpha;
    __device__ __forceinline__ void operator()(const f32x4 (&acc)[2][2][4][2], const Unit& u, int wr, int wc, int fr, int fq) const {
        const int row0 = u.pm * BM + wr * 64 + fr; const int col0 = u.pn * BM + wc * 32 + 4 * fq;
#pragma unroll
        for (int ai = 0; ai < 2; ++ai)
#pragma unroll
            for (int m = 0; m < 4; ++m) { const int row = row0 + ai * HALF + m * 16;
#pragma unroll
                for (int bj = 0; bj < 2; ++bj)
#pragma unroll
                    for (int n = 0; n < 2; ++n) { const int col = col0 + bj * HALF + n * 16; const f32x4 v = acc[ai][bj][m][n];
                        const size_t o = (size_t)row * 1024 + col;
                        if (mode <= 2) {
                            const u32x2 gw = *(const u32x2*)(GT + (size_t)row * 3072 + gofs + col);
                            f32x4 g; g[0] = __uint_as_float(gw.x << 16); g[1] = __uint_as_float(gw.x & 0xffff0000u); g[2] = __uint_as_float(gw.y << 16); g[3] = __uint_as_float(gw.y & 0xffff0000u);
                            f32x4 r = g * v;
                            if (mode >= 1) r += *(const f32x4*)(F + o);
                            if (mode <= 1) *(f32x4*)(F + o) = r;
                            else { u32x2 w; w.x = cvt_pk_bf16(r[0], r[1]); w.y = cvt_pk_bf16(r[2], r[3]); *(u32x2*)(OB + o) = w; }
                        } else if (mode == 3) {
                            const size_t og = o + (size_t)rowoff * 1024;
                            *(f32x4*)(Y + og) = *(const f32x4*)(X + og) * alpha + v;
                        } else if (mode == 4) {
                            f32x4 r; r[0] = fsigmoid(v[0]); r[1] = fsigmoid(v[1]); r[2] = fsigmoid(v[2]); r[3] = fsigmoid(v[3]);
                            *(f32x4*)(F + o) = r;
                        } else if (mode == 5) {
                            *(f32x4*)(Y + o) = *(const f32x4*)(Y + o) * alpha + *(const f32x4*)(F + o) * v;
                        } else {
                            *(f32x4*)(Y + o) = *(const f32x4*)(Y + o) + v;
                        }
                    }
                asm volatile("" ::: "memory"); }
    }
};
template <class Epi, class Sched, bool ALIGN_EPI = false, bool SP2 = false>
__device__ __forceinline__ void gemm_phase(PG8_LAS unsigned char* lds, const Gemm g, const Sched& S, const Epi& E, const int tid_in) {
    const int tid = tid_in, wid = __builtin_amdgcn_readfirstlane(tid >> 6), lane = tid & 63, wr = wid >> 2, wc = wid & 3, fr = lane & 15, fq = lane >> 4;
    const int K = g.K, nt = K / BK;
    unsigned voffA[2], voffB[2];
#pragma unroll
    for (int i = 0; i < 2; ++i) { int R, C; stage_rc(tid * 16 + i * 8192, R, C); const int Rb = Epi::PERM ? ((R & ~31) + perm32(R & 31)) : R;
        voffA[i] = (unsigned)(R * K + C) * 2u; voffB[i] = (unsigned)(Rb * K + C) * 2u; }
    const size_t kstep = (size_t)(BK * 2);
    const size_t hstep = (size_t)HALF * K * 2;
    const size_t tstep = 2 * hstep;
    const unsigned ldsw = (unsigned)wid * 1024u;
    const int aoff = lds_byte(wr * 64 + fr, fq * 8), boff = lds_byte(wc * 32 + fr, fq * 8);
#define PG8_SA(b, h) (((b) * 2 + (h)) * HTB)
#define PG8_SB(b, h) ((4 + (b) * 2 + (h)) * HTB)
#define PG8_STAGE(bufoff, gbase, voff) do { _Pragma("unroll") for (int _i = 0; _i < 2; ++_i) \
        __builtin_amdgcn_global_load_lds((const unsigned*)((const char*)(gbase) + (voff)[_i]), (PG8_LAS unsigned*)(lds + (bufoff) + ldsw + _i * 8192), 16, 0, 0); } while (0)
#define PG8_LDA(dst, b, h) do { _Pragma("unroll") for (int m = 0; m < 4; ++m) _Pragma("unroll") for (int k = 0; k < 2; ++k) dst[m][k] = *(const PG8_LAS bf16x8*)(lds + PG8_SA(b, h) + aoff + m * 2048 + k * 1024); } while (0)
#define PG8_LDB(dst, b, h) do { _Pragma("unroll") for (int n = 0; n < 2; ++n) _Pragma("unroll") for (int k = 0; k < 2; ++k) dst[n][k] = *(const PG8_LAS bf16x8*)(lds + PG8_SB(b, h) + boff + n * 2048 + k * 1024); } while (0)
#define PG8_MMA(ai, bj, At, Bt) do { __builtin_amdgcn_s_setprio(1); _Pragma("unroll") for (int m = 0; m < 4; ++m) _Pragma("unroll") for (int n = 0; n < 2; ++n) _Pragma("unroll") for (int k = 0; k < 2; ++k) \
        acc[ai][bj][m][n] = __builtin_amdgcn_mfma_f32_16x16x32_bf16(Bt[n][k], At[m][k], acc[ai][bj][m][n], 0, 0, 0); __builtin_amdgcn_s_setprio(0); } while (0)
#define PG8_WAIT_V(n) asm volatile("s_waitcnt vmcnt(" #n ")" ::: "memory")
#define PG8_WAIT_L(n) asm volatile("s_waitcnt lgkmcnt(" #n ")" ::: "memory")
#define PG8_BAR __builtin_amdgcn_s_barrier()
#define PG8_SCHED __builtin_amdgcn_sched_barrier(0)
    Unit cur, nxt; int ui = 0;
    if (!S.next(0, cur)) return;
    f32x4 acc[2][2][4][2];
#pragma unroll
    for (int a = 0; a < 2; ++a)
#pragma unroll
        for (int b = 0; b < 2; ++b)
#pragma unroll
            for (int m = 0; m < 4; ++m)
#pragma unroll
                for (int n = 0; n < 2; ++n) acc[a][b][m][n] = (f32x4){0.f, 0.f, 0.f, 0.f};
    bf16x8 At[4][2], B0[2][2], B1[2][2];
    const char* cA = (const char*)g.A + (size_t)cur.pm * tstep; const char* cB = (const char*)g.Bt + (size_t)cur.pn * tstep;
    S.a_ready(cur);
    if constexpr (SP2) {
        PG8_STAGE(PG8_SB(0, 0), cB, voffB); PG8_STAGE(PG8_SB(0, 1), cB + hstep, voffB); PG8_STAGE(PG8_SA(0, 0), cA, voffA); PG8_STAGE(PG8_SA(0, 1), cA + hstep, voffA);
        if (wr == 1) PG8_BAR;
        PG8_WAIT_V(2); PG8_BAR;
        PG8_STAGE(PG8_SB(1, 0), cB + kstep, voffB); PG8_STAGE(PG8_SA(1, 0), cA + kstep, voffA); PG8_STAGE(PG8_SB(1, 1), cB + hstep + kstep, voffB);
        PG8_WAIT_V(6); PG8_BAR;
    } else {
        PG8_STAGE(PG8_SB(0, 0), cB, voffB); PG8_STAGE(PG8_SA(0, 0), cA, voffA); PG8_STAGE(PG8_SB(0, 1), cB + hstep, voffB); PG8_STAGE(PG8_SA(0, 1), cA + hstep, voffA);
        if (wr == 1) PG8_BAR;
        PG8_WAIT_V(4); PG8_BAR;
        PG8_STAGE(PG8_SB(1, 0), cB + kstep, voffB); PG8_STAGE(PG8_SA(1, 0), cA + kstep, voffA); PG8_STAGE(PG8_SB(1, 1), cB + hstep + kstep, voffB);
        PG8_WAIT_V(6); PG8_BAR;
    }
    for (;;) {
        const bool has_next = S.next(ui + 1, nxt);
        const char* nA = has_next ? (const char*)g.A + (size_t)nxt.pm * tstep : cA; const char* nB = has_next ? (const char*)g.Bt + (size_t)nxt.pn * tstep : cB;
        for (int t = 0; t < nt; t += 2) {
            const bool last = (t == nt - 2);
            const char* a1 = cA + (size_t)(t + 1) * kstep;
            const char* a2 = last ? nA : cA + (size_t)(t + 2) * kstep; const char* b2 = last ? nB : cB + (size_t)(t + 2) * kstep;
            const char* a3 = a2 + kstep; const char* b3 = b2 + kstep;
            if (last && has_next) S.a_ready(nxt);
            if constexpr (SP2) {
            PG8_LDB(B0, 0, 0); PG8_LDB(B1, 0, 1); PG8_SCHED; PG8_LDA(At, 0, 0); PG8_STAGE(PG8_SA(1, 1), a1 + hstep, voffA);
            PG8_WAIT_V(8); PG8_WAIT_L(0); PG8_BAR; PG8_MMA(0, 0, At, B0); PG8_MMA(0, 1, At, B1); PG8_BAR; PG8_SCHED;
            PG8_LDA(At, 0, 1); PG8_STAGE(PG8_SB(0, 0), b2, voffB); PG8_STAGE(PG8_SB(0, 1), b2 + hstep, voffB); PG8_STAGE(PG8_SA(0, 0), a2, voffA);
            PG8_WAIT_V(8); PG8_WAIT_L(0); PG8_BAR; PG8_MMA(1, 0, At, B0); PG8_MMA(1, 1, At, B1); PG8_BAR; PG8_SCHED;
            PG8_LDB(B0, 1, 0); PG8_LDB(B1, 1, 1); PG8_SCHED; PG8_LDA(At, 1, 0); PG8_STAGE(PG8_SA(0, 1), a2 + hstep, voffA);
            PG8_WAIT_V(8); PG8_WAIT_L(0); PG8_BAR; PG8_MMA(0, 0, At, B0); PG8_MMA(0, 1, At, B1); PG8_BAR; PG8_SCHED;
            PG8_LDA(At, 1, 1); PG8_STAGE(PG8_SB(1, 0), b3, voffB); PG8_STAGE(PG8_SB(1, 1), b3 + hstep, voffB); PG8_STAGE(PG8_SA(1, 0), a3, voffA);
            PG8_WAIT_V(8); PG8_WAIT_L(0); PG8_BAR; PG8_MMA(1, 0, At, B0); PG8_MMA(1, 1, At, B1); PG8_BAR; PG8_SCHED;
            } else {
            PG8_LDB(B0, 0, 0); PG8_SCHED; PG8_LDA(At, 0, 0); PG8_STAGE(PG8_SA(1, 1), a1 + hstep, voffA);
            PG8_WAIT_L(8); PG8_BAR; PG8_WAIT_L(0); PG8_MMA(0, 0, At, B0); PG8_BAR; PG8_SCHED;
            PG8_LDB(B1, 0, 1); PG8_STAGE(PG8_SB(0, 0), b2, voffB);
            PG8_BAR; PG8_WAIT_L(0); PG8_MMA(0, 1, At, B1); PG8_BAR;
            PG8_LDA(At, 0, 1); PG8_STAGE(PG8_SA(0, 0), a2, voffA);
            PG8_BAR; PG8_WAIT_L(0); PG8_MMA(1, 0, At, B0); PG8_BAR; PG8_SCHED;
            PG8_STAGE(PG8_SB(0, 1), b2 + hstep, voffB);
            PG8_WAIT_V(6); PG8_BAR; PG8_MMA(1, 1, At, B1); PG8_BAR;
            PG8_LDB(B0, 1, 0); PG8_SCHED; PG8_LDA(At, 1, 0); PG8_STAGE(PG8_SA(0, 1), a2 + hstep, voffA);
            PG8_WAIT_L(8); PG8_BAR; PG8_WAIT_L(0); PG8_MMA(0, 0, At, B0); PG8_BAR; PG8_SCHED;
            PG8_LDB(B1, 1, 1); PG8_STAGE(PG8_SB(1, 0), b3, voffB);
            PG8_BAR; PG8_WAIT_L(0); PG8_MMA(0, 1, At, B1); PG8_BAR;
            PG8_LDA(At, 1, 1); PG8_STAGE(PG8_SA(1, 0), a3, voffA);
            PG8_BAR; PG8_WAIT_L(0); PG8_MMA(1, 0, At, B0); PG8_BAR; PG8_SCHED;
            PG8_STAGE(PG8_SB(1, 1), b3 + hstep, voffB);
            PG8_WAIT_V(6); PG8_BAR; PG8_MMA(1, 1, At, B1); PG8_BAR;
            }
        }
        if constexpr (ALIGN_EPI) { if (wr == 0) PG8_BAR; }
        if constexpr (!Epi::AFTER_DRAIN) { E(acc, cur, wr, wc, fr, fq); S.done(cur); }
        if (!has_next) break;
#pragma unroll
        for (int a = 0; a < 2; ++a)
#pragma unroll
            for (int b = 0; b < 2; ++b)
#pragma unroll
                for (int m = 0; m < 4; ++m)
#pragma unroll
                    for (int n = 0; n < 2; ++n) acc[a][b][m][n] = (f32x4){0.f, 0.f, 0.f, 0.f};
        cur = nxt; cA = nA; cB = nB; ++ui;
        if constexpr (ALIGN_EPI) { if (wr == 1) PG8_BAR; }
    }
    PG8_WAIT_V(0);
    if constexpr (!ALIGN_EPI) { if (wr == 0) PG8_BAR; }
    PG8_BAR;
    if constexpr (Epi::AFTER_DRAIN) { E.fused(acc, cur, wr, wc, fr, fq, lds, wid, lane); S.done(cur); }
#undef PG8_SA
#undef PG8_SB
#undef PG8_STAGE
#undef PG8_LDA
#undef PG8_LDB
#undef PG8_MMA
#undef PG8_WAIT_V
#undef PG8_WAIT_L
#undef PG8_BAR
#undef PG8_SCHED
}
}
namespace att {
#define LAS __attribute__((address_space(3)))
typedef unsigned short bf16_t;
typedef short bf16x8 __attribute__((ext_vector_type(8)));
typedef float f32x16 __attribute__((ext_vector_type(16)));
typedef float f32x4 __attribute__((ext_vector_type(4)));
typedef unsigned u32x4 __attribute__((ext_vector_type(4)));
typedef unsigned u32x2 __attribute__((ext_vector_type(2)));
constexpr float LOG2E = 1.4426950408889634f;
constexpr float NEG = -1.0e30f;
constexpr int LDQK = 5120;
__device__ __forceinline__ f32x16 mfma(bf16x8 a, bf16x8 b, f32x16 c) { return __builtin_amdgcn_mfma_f32_32x32x16_bf16(a, b, c, 0, 0, 0); }
__device__ __forceinline__ bf16x8 ld16(const bf16_t* p) { return *(const bf16x8*)p; }
__device__ __forceinline__ unsigned cvtpk(float lo, float hi) { typedef float f2 __attribute__((ext_vector_type(2))); typedef __bf16 b2 __attribute__((ext_vector_type(2))); f2 v = {lo, hi}; b2 b = __builtin_convertvector(v, b2); return __builtin_bit_cast(unsigned, b); }
__device__ __forceinline__ bf16x8 pack8(float a0, float a1, float a2, float a3, float a4, float a5, float a6, float a7) {
    u32x4 w; w.x = cvtpk(a0, a1); w.y = cvtpk(a2, a3); w.z = cvtpk(a4, a5); w.w = cvtpk(a6, a7); return __builtin_bit_cast(bf16x8, w); }
__device__ __forceinline__ float ex2(float x) { return __builtin_amdgcn_exp2f(x); }
__device__ __forceinline__ float lg2(float x) { return __builtin_amdgcn_logf(x); }
__device__ __forceinline__ int kperm(int m) { return ((m >> 4) << 4) | (((m >> 2) & 1) << 3) | (((m >> 3) & 1) << 2) | (m & 3); }
__device__ __forceinline__ int rel_bucket(int d) { if (d < 16) return d; const float lr = logf((float)d / 16.0f) / 4.852030263919617f; const int large = 16 + (int)(lr * 16.0f); return large < 31 ? large : 31; }
__device__ __forceinline__ float xchg32(float x, int hi) { const auto rr = __builtin_amdgcn_permlane32_swap(__float_as_uint(x), __float_as_uint(x), false, false); return __uint_as_float(hi ? rr[0] : rr[1]); }
#define KL(r, hi) (16 * ((r) >> 3) + 8 * (hi) + ((r) & 7))

#ifndef FAST1
#define FAST1 1
#endif
#ifndef FAST2
#define FAST2 1
#endif
constexpr int KROW = 272, VROW = 144, KBUF = 64 * KROW, VBUF = 128 * VROW;
__device__ __forceinline__ void attnA_unit(LAS unsigned char* lds, const bf16_t* QK, const bf16_t* VT, bf16_t* ODA, int Mc, int b, int h, int p,
                                           const float* lam4, const float* normg, const float* relb, float lam_init, int tid, int wave, int lane) {
    LAS float* tbl = (LAS float*)lds;
    LAS unsigned char* Kb = lds + 16640; LAS unsigned char* Vb = lds + 16640 + 2 * KBUF;
    asm volatile("" : "+v"(tid), "+v"(lane));
    LAS float* red = (LAS float*)(lds + 129024);
    __syncthreads();
    for (int d = tid; d < 4096 + 32; d += 512) tbl[d] = d < 32 ? 0.f : relb[rel_bucket(d - 32) * 16 + h] * LOG2E;
    if (tid < 128) red[tid] = lam4[(tid & 63) + 2 * (tid & 64)] * lam4[64 + (tid & 63) + 2 * (tid & 64)];
    const int hi = lane >> 5, ql = lane & 31;
    const int sb = (wave < 4) ? (4 * p + wave) : (4 * (31 - p) + 3 - (wave - 4));
    const int qpos = sb * 32 + ql;
    const size_t tokbase = (size_t)b * 4096;
    const float SC = 0.125f * LOG2E;
    const int NT = 64 - 2 * p;
    const bf16_t* qrow = QK + (tokbase + qpos) * LDQK + h * 128 + hi * 8;
    bf16x8 qf[2][4];
#pragma unroll
    for (int mp = 0; mp < 2; ++mp)
#pragma unroll
        for (int st = 0; st < 4; ++st) qf[mp][st] = ld16(qrow + mp * 64 + st * 16);
    const bf16_t* kg = QK + (tokbase + (tid >> 4)) * LDQK + 512 + h * 128 + (tid & 15) * 8;
    const int kl_off = (tid >> 4) * KROW + (tid & 15) * 16;
    const bf16_t* vg = VT + (size_t)(h * 128 + (tid >> 3)) * Mc + tokbase + (tid & 7) * 8;
    const int vl_off = (tid >> 3) * VROW + (tid & 7) * 16;
    const int ka_off = kperm(ql) * KROW + hi * 16, va_off = ql * VROW + hi * 16;
    bf16x8 kp0, kp1, vp0, vp1;
    kp0 = ld16(kg); kp1 = ld16(kg + (size_t)32 * LDQK);
    *(LAS bf16x8*)(Kb + kl_off) = kp0; *(LAS bf16x8*)(Kb + kl_off + 32 * KROW) = kp1;
    __syncthreads();
    float mx[2] = {NEG, NEG}, sm[2] = {0.f, 0.f};
    for (int jt = 0; jt < NT; ++jt) {
        const LAS unsigned char* kb = Kb + (jt & 1) * KBUF;
        const bool more = jt + 1 < NT;
        if (more) { const bf16_t* g2 = kg + (size_t)(64 * (jt + 1)) * LDQK; kp0 = ld16(g2); kp1 = ld16(g2 + (size_t)32 * LDQK); }
        if (2 * jt <= sb) {
#pragma unroll
            for (int hf = 0; hf < 2; ++hf) {
                const LAS unsigned char* kr = kb + ka_off + hf * 32 * KROW;
                const int dbase = qpos - (2 * jt + hf) * 32 - 8 * hi;
                const LAS float* tp = tbl + (dbase + 32 - 23);
                f32x16 S[2];
#pragma unroll
                for (int mp = 0; mp < 2; ++mp) { f32x16 s = {0.f, 0.f, 0.f, 0.f, 0.f, 0.f, 0.f, 0.f, 0.f, 0.f, 0.f, 0.f, 0.f, 0.f, 0.f, 0.f};
#pragma unroll
                    for (int st = 0; st < 4; ++st) s = mfma(*(const LAS bf16x8*)(kr + mp * 128 + st * 32), qf[mp][st], s);
                    S[mp] = s; }
                float mt0 = NEG, mt1 = NEG;
#pragma unroll
                for (int r = 0; r < 16; ++r) { const int c = (r & 7) + 16 * (r >> 3); const float bb = tp[23 - c]; const bool ok = c <= dbase;
                    const float v0 = ok ? S[0][r] * SC + bb : NEG, v1 = ok ? S[1][r] * SC + bb : NEG; S[0][r] = v0; S[1][r] = v1; mt0 = fmaxf(mt0, v0); mt1 = fmaxf(mt1, v1); }
                const float mn0 = fmaxf(mx[0], mt0), mn1 = fmaxf(mx[1], mt1); float a0 = 0.f, a1 = 0.f;
#pragma unroll
                for (int r = 0; r < 16; ++r) { a0 += ex2(S[0][r] - mn0); a1 += ex2(S[1][r] - mn1); }
                sm[0] = sm[0] * ex2(mx[0] - mn0) + a0; mx[0] = mn0; sm[1] = sm[1] * ex2(mx[1] - mn1) + a1; mx[1] = mn1;
            }
        }
        if (more) { LAS unsigned char* kn = Kb + ((jt + 1) & 1) * KBUF; *(LAS bf16x8*)(kn + kl_off) = kp0; *(LAS bf16x8*)(kn + kl_off + 32 * KROW) = kp1; }
        __syncthreads();
    }
    float Mf[2], iL[2];
#pragma unroll
    for (int mp = 0; mp < 2; ++mp) { const float mo = xchg32(mx[mp], hi), so = xchg32(sm[mp], hi); const float M = fmaxf(mx[mp], mo);
        const float L = sm[mp] * ex2(mx[mp] - M) + so * ex2(mo - M); Mf[mp] = M; iL[mp] = 1.0f / L; }
    float s0 = 0.f, s1 = 0.f;
#pragma unroll 8
    for (int i = 0; i < 64; ++i) { s0 += red[i]; s1 += red[64 + i]; }
    const float lam = expf(s0) - expf(s1) + lam_init;
    const float c0 = iL[0], c1 = lam * iL[1];
    f32x16 O[4];
#pragma unroll
    for (int k = 0; k < 4; ++k) O[k] = (f32x16){0.f, 0.f, 0.f, 0.f, 0.f, 0.f, 0.f, 0.f, 0.f, 0.f, 0.f, 0.f, 0.f, 0.f, 0.f, 0.f};
    kp0 = ld16(kg); kp1 = ld16(kg + (size_t)32 * LDQK); vp0 = ld16(vg); vp1 = ld16(vg + (size_t)64 * Mc);
    *(LAS bf16x8*)(Kb + kl_off) = kp0; *(LAS bf16x8*)(Kb + kl_off + 32 * KROW) = kp1;
    *(LAS bf16x8*)(Vb + vl_off) = vp0; *(LAS bf16x8*)(Vb + vl_off + 64 * VROW) = vp1;
    __syncthreads();
    for (int jt = 0; jt < NT; ++jt) {
        const LAS unsigned char* kb = Kb + (jt & 1) * KBUF; const LAS unsigned char* vb = Vb + (jt & 1) * VBUF;
        const bool more = jt + 1 < NT;
        if (more) { const bf16_t* g2 = kg + (size_t)(64 * (jt + 1)) * LDQK; kp0 = ld16(g2); kp1 = ld16(g2 + (size_t)32 * LDQK);
                    const bf16_t* g3 = vg + 64 * (jt + 1); vp0 = ld16(g3); vp1 = ld16(g3 + (size_t)64 * Mc); }
        if (2 * jt <= sb) {
#pragma unroll
            for (int hf = 0; hf < 2; ++hf) {
                const LAS unsigned char* kr = kb + ka_off + hf * 32 * KROW;
                const int dbase = qpos - (2 * jt + hf) * 32 - 8 * hi;
                const LAS float* tp = tbl + (dbase + 32 - 23);
                f32x16 s0v = {0.f, 0.f, 0.f, 0.f, 0.f, 0.f, 0.f, 0.f, 0.f, 0.f, 0.f, 0.f, 0.f, 0.f, 0.f, 0.f}, s1v = s0v;
#pragma unroll
                for (int st = 0; st < 4; ++st) { s0v = mfma(*(const LAS bf16x8*)(kr + st * 32), qf[0][st], s0v); s1v = mfma(*(const LAS bf16x8*)(kr + 128 + st * 32), qf[1][st], s1v); }
                float w[16];
#pragma unroll
                for (int r = 0; r < 16; ++r) { const int c = (r & 7) + 16 * (r >> 3); const float bb = tp[23 - c];
                    const float e0 = ex2(s0v[r] * SC + (bb - Mf[0])), e1 = ex2(s1v[r] * SC + (bb - Mf[1]));
                    w[r] = c <= dbase ? (e0 * c0 - e1 * c1) : 0.f; }
                const bf16x8 pb0 = pack8(w[0], w[1], w[2], w[3], w[4], w[5], w[6], w[7]), pb1 = pack8(w[8], w[9], w[10], w[11], w[12], w[13], w[14], w[15]);
                const LAS unsigned char* vr = vb + va_off + hf * 64;
#pragma unroll
                for (int k = 0; k < 4; ++k) { O[k] = mfma(*(const LAS bf16x8*)(vr + k * 32 * VROW), pb0, O[k]); O[k] = mfma(*(const LAS bf16x8*)(vr + k * 32 * VROW + 32), pb1, O[k]); }
            }
        }
        if (more) { LAS unsigned char* kn = Kb + ((jt + 1) & 1) * KBUF; LAS unsigned char* vn = Vb + ((jt + 1) & 1) * VBUF;
            *(LAS bf16x8*)(kn + kl_off) = kp0; *(LAS bf16x8*)(kn + kl_off + 32 * KROW) = kp1; *(LAS bf16x8*)(vn + vl_off) = vp0; *(LAS bf16x8*)(vn + vl_off + 64 * VROW) = vp1; }
        __syncthreads();
    }
    float ss = 0.f;
#pragma unroll
    for (int k = 0; k < 4; ++k)
#pragma unroll
        for (int r = 0; r < 16; ++r) ss += O[k][r] * O[k][r];
    ss += xchg32(ss, hi);
    const float rs = (1.0f / sqrtf(ss * (1.0f / 128.0f) + 1e-5f)) * (1.0f - lam_init);
    bf16_t* orow = ODA + (tokbase + qpos) * 512 + h * 128 + 4 * hi;
#pragma unroll
    for (int k = 0; k < 4; ++k)
#pragma unroll
        for (int rr = 0; rr < 4; ++rr) { const int dv = 32 * k + 8 * rr; const f32x4 g = *(const f32x4*)(normg + dv + 4 * hi);
            u32x2 o; o.x = cvtpk(O[k][4 * rr] * rs * g[0], O[k][4 * rr + 1] * rs * g[1]); o.y = cvtpk(O[k][4 * rr + 2] * rs * g[2], O[k][4 * rr + 3] * rs * g[3]);
            *(u32x2*)(orow + dv) = o; }
}

__device__ __forceinline__ void attnB_unit(const bf16_t* QK, const bf16_t* VT, bf16_t* OSB, int Mc, int b, int h, int qb, int wave, int lane) {
    asm volatile("" : "+v"(lane));
    const int hi = lane >> 5, ql = lane & 31;
    const int sb = qb * 8 + wave; const int qpos = sb * 32 + ql;
    const size_t tokbase = (size_t)b * 4096;
    const float SC = 0.125f * LOG2E;
    const bf16_t* qrow = QK + (tokbase + qpos) * LDQK + 1024 + h * 64 + hi * 8;
    bf16x8 qf[4];
#pragma unroll
    for (int st = 0; st < 4; ++st) qf[st] = ld16(qrow + st * 16);
    const bf16_t* kbase = QK + (tokbase + kperm(ql)) * LDQK + 1536 + h * 64 + hi * 8;
    const bf16_t* vbase = VT + (size_t)(512 + h * 64 + ql) * Mc + tokbase + 8 * hi;
    f32x16 O[2];
#pragma unroll
    for (int k = 0; k < 2; ++k) O[k] = (f32x16){0.f, 0.f, 0.f, 0.f, 0.f, 0.f, 0.f, 0.f, 0.f, 0.f, 0.f, 0.f, 0.f, 0.f, 0.f, 0.f};
    float carry = 0.f;
    for (int j = sb; j >= 0; --j) {
        const bf16_t* kr = kbase + (size_t)(j * 32) * LDQK;
        f32x16 s = {0.f, 0.f, 0.f, 0.f, 0.f, 0.f, 0.f, 0.f, 0.f, 0.f, 0.f, 0.f, 0.f, 0.f, 0.f, 0.f};
#pragma unroll
        for (int st = 0; st < 4; ++st) s = mfma(ld16(kr + st * 16), qf[st], s);
        const int dbase = qpos - j * 32 - 8 * hi;
        float lk[16], zz[16];
#pragma unroll
        for (int r = 0; r < 16; ++r) { const int d = dbase - (r & 7) - 16 * (r >> 3); const float z2 = s[r] * SC;
            const float sp = fmaxf(z2, 0.f) + lg2(1.0f + ex2(-fabsf(z2)));
            lk[r] = d > 0 ? -sp : 0.f; zz[r] = d > 0 ? z2 : NEG; }
        float sf[16]; float T0 = 0.f, T1 = 0.f;
#pragma unroll
        for (int r = 7; r >= 0; --r) { sf[r] = T0; T0 += lk[r]; }
#pragma unroll
        for (int r = 15; r >= 8; --r) { sf[r] = T1; T1 += lk[r]; }
        const float P0 = xchg32(T0, hi), P1 = xchg32(T1, hi);
        const float add0 = carry + (hi == 0 ? (P0 + T1 + P1) : (P1 + T1));
        const float add1 = carry + (hi == 0 ? P1 : 0.f);
        float a[16];
#pragma unroll
        for (int r = 0; r < 16; ++r) a[r] = ex2(zz[r] + lk[r] + sf[r] + (r < 8 ? add0 : add1));
        const bf16x8 pb0 = pack8(a[0], a[1], a[2], a[3], a[4], a[5], a[6], a[7]), pb1 = pack8(a[8], a[9], a[10], a[11], a[12], a[13], a[14], a[15]);
        const bf16_t* vr = vbase + j * 32;
#pragma unroll
        for (int k = 0; k < 2; ++k) { O[k] = mfma(ld16(vr + (size_t)(k * 32) * Mc), pb0, O[k]); O[k] = mfma(ld16(vr + (size_t)(k * 32) * Mc + 16), pb1, O[k]); }
        carry += (T0 + T1) + (P0 + P1);
        if (__all(carry < -160.0f)) break;
    }
    bf16_t* orow = OSB + (tokbase + qpos) * 512 + h * 64 + 4 * hi;
#pragma unroll
    for (int k = 0; k < 2; ++k)
#pragma unroll
        for (int rr = 0; rr < 4; ++rr) { u32x2 o; o.x = cvtpk(O[k][4 * rr], O[k][4 * rr + 1]); o.y = cvtpk(O[k][4 * rr + 2], O[k][4 * rr + 3]); *(u32x2*)(orow + 32 * k + 8 * rr) = o; }
}

__device__ __forceinline__ void attnC_unit(LAS float* tblC, const bf16_t* QK, const bf16_t* VT, float* SCR, float* LSE, bf16_t* ODL, int Mc, int b, int hh, int R,
                                           const float* relb, int tid, int wave, int lane) {
    asm volatile("" : "+v"(tid), "+v"(lane));
    __syncthreads();
    for (int i = tid; i < 3 * 129; i += 512) { const int g = i / 129, j = i - g * 129; tblC[g * 132 + j] = relb[rel_bucket(j << (2 * g)) * 16 + 4 + g * 4 + hh] * LOG2E; }
    __syncthreads();
    const int hi = lane >> 5, ql = lane & 31;
    const size_t tokbase = (size_t)b * 4096;
    const float SC = 0.08838834764831845f * LOG2E;
#pragma unroll 1
    for (int g = 0; g < 3; ++g) {
        const int ld = 2 * g, nmb = 16 >> ld;
#pragma unroll 1
        for (int tt = 0; tt < 2; ++tt) {
            const int t = wave * 2 + tt; const int res = t / nmb, mb = t - res * nmb;
            const int m0 = R * (512 >> ld) + 32 * mb;
            const int token = ((m0 + ql) << ld) + res;
            const bf16_t* qrow = QK + (tokbase + token) * LDQK + 2048 + g * 512 + hh * 128 + hi * 8;
            bf16x8 qf[8];
#pragma unroll
            for (int st = 0; st < 8; ++st) qf[st] = ld16(qrow + st * 16);
            f32x16 O[4];
#pragma unroll
            for (int k = 0; k < 4; ++k) O[k] = (f32x16){0.f, 0.f, 0.f, 0.f, 0.f, 0.f, 0.f, 0.f, 0.f, 0.f, 0.f, 0.f, 0.f, 0.f, 0.f, 0.f};
            const bf16_t* kbase = QK + (tokbase + res) * LDQK + 3584 + g * 512 + hh * 128 + hi * 8;
            const bf16_t* vbase = VT + (size_t)(1024 + g * 512 + hh * 128 + ql) * Mc + tokbase + res * (4096 >> ld) + 8 * hi;
            const LAS float* tg = tblC + g * 132;
            float M = NEG, Ll = 0.f;
            const int jt0 = m0 >= 128 ? 0 : ((128 - m0) >> 5);
#pragma unroll 1
            for (int jt = jt0; jt < 5; ++jt) {
                const int mt0 = m0 - 128 + 32 * jt;
                const bf16_t* kr = kbase + ((size_t)(mt0 + kperm(ql)) << ld) * LDQK;
                f32x16 s = {0.f, 0.f, 0.f, 0.f, 0.f, 0.f, 0.f, 0.f, 0.f, 0.f, 0.f, 0.f, 0.f, 0.f, 0.f, 0.f};
#pragma unroll
                for (int st = 0; st < 8; ++st) s = mfma(ld16(kr + st * 16), qf[st], s);
                const int jb = 128 - 32 * jt + ql - 8 * hi;
                float mt = NEG;
#pragma unroll
                for (int r = 0; r < 16; ++r) { const int jd = jb - ((r & 7) + 16 * (r >> 3));
                    const bool ok = (jd >= 0) && (jd <= 128);
                    const float v = ok ? s[r] * SC + tg[jd < 0 ? 0 : (jd > 128 ? 128 : jd)] : NEG; s[r] = v; mt = fmaxf(mt, v); }
                mt = fmaxf(mt, xchg32(mt, hi));
                const float mn = fmaxf(M, mt), al = ex2(M - mn); M = mn;
                float a = 0.f;
#pragma unroll
                for (int r = 0; r < 16; ++r) { const float e = ex2(s[r] - mn); s[r] = e; a += e; }
                Ll = Ll * al + a;
#pragma unroll
                for (int k = 0; k < 4; ++k)
#pragma unroll
                    for (int r = 0; r < 16; ++r) O[k][r] *= al;
                const bf16x8 pb0 = pack8(s[0], s[1], s[2], s[3], s[4], s[5], s[6], s[7]), pb1 = pack8(s[8], s[9], s[10], s[11], s[12], s[13], s[14], s[15]);
                const bf16_t* vr = vbase + mt0;
#pragma unroll
                for (int k = 0; k < 4; ++k) { O[k] = mfma(ld16(vr + (size_t)(k * 32) * Mc), pb0, O[k]); O[k] = mfma(ld16(vr + (size_t)(k * 32) * Mc + 16), pb1, O[k]); }
            }
            const float L = Ll + xchg32(Ll, hi);
            { const float iL = 1.0f / L;
#pragma unroll
              for (int k = 0; k < 4; ++k)
#pragma unroll
                for (int r = 0; r < 16; ++r) O[k][r] *= iL; }
            float lse = M + lg2(L);
            float* srow = SCR + (tokbase + token) * 512 + hh * 128 + 4 * hi;
            float* lp = LSE + (tokbase + token) * 4 + hh;
            if (g > 0) {
                const float lo = *lp; const float mxl = fmaxf(lo, lse);
                const float ea = ex2(lo - mxl), eb = ex2(lse - mxl); const float inv = 1.0f / (ea + eb);
                const float wa = ea * inv, wb = eb * inv; lse = mxl + lg2(ea + eb);
#pragma unroll
                for (int k = 0; k < 4; ++k)
#pragma unroll
                    for (int rr = 0; rr < 4; ++rr) { const f32x4 old = *(const f32x4*)(srow + 32 * k + 8 * rr);
#pragma unroll
                        for (int e = 0; e < 4; ++e) O[k][4 * rr + e] = wa * old[e] + wb * O[k][4 * rr + e]; }
            }
            if (g < 2) {
#pragma unroll
                for (int k = 0; k < 4; ++k)
#pragma unroll
                    for (int rr = 0; rr < 4; ++rr) *(f32x4*)(srow + 32 * k + 8 * rr) = (f32x4){O[k][4 * rr], O[k][4 * rr + 1], O[k][4 * rr + 2], O[k][4 * rr + 3]};
                if (hi == 0) *lp = lse;
            } else {
                bf16_t* orow = ODL + (tokbase + token) * 512 + hh * 128 + 4 * hi;
#pragma unroll
                for (int k = 0; k < 4; ++k)
#pragma unroll
                    for (int rr = 0; rr < 4; ++rr) { u32x2 o; o.x = cvtpk(O[k][4 * rr], O[k][4 * rr + 1]); o.y = cvtpk(O[k][4 * rr + 2], O[k][4 * rr + 3]); *(u32x2*)(orow + 32 * k + 8 * rr) = o; }
            }
        }
        if (g < 2) __syncthreads();
    }
}
}
constexpr int MTOK = 32768, DM = 1024, DFF = 4096, NPROJ = 10752, MC = 16384, NLAYER = 4;
constexpr size_t MiB = 1u << 20;
constexpr size_t WS_WIN = 1 * MiB, WS_WBR = 22 * MiB, WS_WOUT = 25 * MiB, WS_WUP = 27 * MiB, WS_WDOWN = 35 * MiB, WS_WG = 43 * MiB, WS_WP = 45 * MiB;
constexpr size_t WS_PB = 46 * MiB, WS_XB = 62 * MiB, WS_QK = 126 * MiB, WS_VT = 286 * MiB, WS_GT = 366 * MiB, WS_HID = 126 * MiB;
constexpr size_t WS_ODA = 462 * MiB, WS_OSB = 478 * MiB, WS_ODL = 494 * MiB, WS_SCR = 510 * MiB, WS_LSE = 542 * MiB, WS_MF = 543 * MiB, WS_MRG = 607 * MiB, WS_TMP = 462 * MiB, WS_END = 639 * MiB;
constexpr int LDS_BYTES = 143360;
constexpr float ALPHA = 1.681792830507429f;
typedef unsigned short bf16;
typedef unsigned v4u __attribute__((ext_vector_type(4)));
typedef float f32x4 __attribute__((ext_vector_type(4)));
__device__ __forceinline__ unsigned pk2(float lo, float hi) { return pg8::cvt_pk_bf16(lo, hi); }
__device__ __forceinline__ float wave_sum(float v, int lane) {
#pragma unroll
    for (int o = 1; o < 64; o <<= 1) v += __int_as_float(__builtin_amdgcn_ds_bpermute((lane ^ o) << 2, __float_as_int(v)));
    return v; }
__device__ __forceinline__ void transpose_item(const float* W, int K, int N, bf16* WT, LAS float* scr, int item, int lane) {
    const int nblk = N / 32, kb = item / nblk, nb = item - kb * nblk, k0 = 64 * kb, n0 = 32 * nb;
#pragma unroll 8
    for (int i = 0; i < 32; ++i) { const int kk = 2 * i + (lane >> 5); scr[kk * 33 + (lane & 31)] = W[(size_t)(k0 + kk) * N + n0 + (lane & 31)]; }
    asm volatile("s_waitcnt lgkmcnt(0)" ::: "memory");
    const int c = lane & 7;
#pragma unroll
    for (int j = 0; j < 4; ++j) { const int n = (lane >> 3) + 8 * j; const LAS float* s = scr + (8 * c) * 33 + n;
        v4u o; o.x = pk2(s[0 * 33], s[1 * 33]); o.y = pk2(s[2 * 33], s[3 * 33]); o.z = pk2(s[4 * 33], s[5 * 33]); o.w = pk2(s[6 * 33], s[7 * 33]);
        *(v4u*)(WT + (size_t)(n0 + n) * K + k0 + 8 * c) = o; }
    asm volatile("s_waitcnt lgkmcnt(0)" ::: "memory");
}
#define XB_TMO      128
#define XB_XCNT(j)  (256  + 64 * (j))
#define XB_XSUB(j)  (1280 + 64 * (j))
#define XB_XGEN(j)  (2304 + 64 * (j))
#define XB_TOP      3328
#define XB_TOPGEN   3392
#define XCD_BAR_WORDS 3456
#define XB_SPIN_CAP (1u << 18)

__device__ __forceinline__ unsigned xb_ld(unsigned* p)              { return __hip_atomic_load(p, __ATOMIC_RELAXED, __HIP_MEMORY_SCOPE_AGENT); }
__device__ __forceinline__ unsigned xb_add(unsigned* p, unsigned v) { return __hip_atomic_fetch_add(p, v, __ATOMIC_RELAXED, __HIP_MEMORY_SCOPE_AGENT); }
__device__ __forceinline__ unsigned xb_xcc_id() { return (unsigned)__builtin_amdgcn_s_getreg((3 << 11) | 20) & 0xFu; }
#define XB_SPIN(cond, bar) do { unsigned _sp = 0; while (cond) { __builtin_amdgcn_s_sleep(1); \
    if ((++_sp & 255u) == 0u) { if (xb_ld(&(bar)[XB_TMO])) break; if (_sp > XB_SPIN_CAP) { atomicAdd(&(bar)[XB_TMO], 1u); break; } } } } while (0)

struct XcdBarrier {
    unsigned* bar; unsigned x;
    volatile LAS unsigned* st;
};

__device__ __forceinline__ XcdBarrier xcd_barrier_post(unsigned* bar, volatile LAS unsigned* st) {
    XcdBarrier b; b.bar = bar; b.x = xb_xcc_id(); b.st = st;
    if (threadIdx.x == 0) (void)xb_add(&bar[XB_XCNT(b.x)], 1u);
    return b;
}
__device__ __forceinline__ void xcd_barrier_complete(unsigned* bar, unsigned x, unsigned& nloc, unsigned& nx) {
    const unsigned G = gridDim.x * gridDim.y * gridDim.z;
    unsigned sum, cnt, mine, sp = 0u;
    for (;;) {
        sum = 0u; cnt = 0u; mine = 0u;
#pragma unroll
        for (unsigned j = 0; j < 16; ++j) { const unsigned c = xb_ld(&bar[XB_XCNT(j)]); sum += c; cnt += (c > 0u) ? 1u : 0u; mine = (j == x) ? c : mine; }
        if (sum == G) break;
        __builtin_amdgcn_s_sleep(1);
        if ((++sp & 255u) == 0u) { if (xb_ld(&bar[XB_TMO])) break; if (sp > XB_SPIN_CAP) { atomicAdd(&bar[XB_TMO], 1u); break; } }
    }
    nloc = mine > 0u ? mine : 1u; nx = cnt > 0u ? cnt : 1u;
}

__device__ __forceinline__ void xcd_barrier(const XcdBarrier& b) {
    asm volatile("s_waitcnt vmcnt(0)" ::: "memory");
    __syncthreads();
    if (threadIdx.x == 0) {
        unsigned* bar = b.bar;
        __builtin_amdgcn_s_waitcnt(0);
        unsigned nloc = b.st[0], nx = b.st[1];
        if (nloc == 0u) { xcd_barrier_complete(bar, b.x, nloc, nx); b.st[0] = nloc; b.st[1] = nx; }
        const unsigned old = xb_add(&bar[XB_XSUB(b.x)], 1u);
        const unsigned gen = old / nloc;
        if (old + 1u == (gen + 1u) * nloc) {
            __builtin_amdgcn_fence(__ATOMIC_RELEASE, "agent");
            asm volatile("s_waitcnt vmcnt(0)" ::: "memory");
            const unsigned og = xb_add(&bar[XB_TOP], 1u);
            const unsigned tg = og / nx;
            if (og + 1u == (tg + 1u) * nx) xb_add(&bar[XB_TOPGEN], 1u);
            else XB_SPIN(xb_ld(&bar[XB_TOPGEN]) == tg, bar);
            __builtin_amdgcn_fence(__ATOMIC_ACQUIRE, "agent");
            xb_add(&bar[XB_XGEN(b.x)], 1u);
            asm volatile("s_waitcnt vmcnt(0)" ::: "memory");
        } else {
            XB_SPIN(xb_ld(&bar[XB_XGEN(b.x)]) == gen, bar);
            __builtin_amdgcn_fence(__ATOMIC_ACQUIRE, "agent");
            asm volatile("s_waitcnt vmcnt(0)" ::: "memory");
        }
    }
    __syncthreads();
}

struct Args { const float* in[18]; float* out; unsigned char* ws; };
constexpr int PTAB_OFF = 131072 + 4096;
__device__ __forceinline__ const float* ldptr(LAS unsigned char* lds, int i) {
    const unsigned long long v = ((LAS unsigned long long*)(lds + PTAB_OFF))[i];
    const unsigned lo = __builtin_amdgcn_readfirstlane((unsigned)v), hi = __builtin_amdgcn_readfirstlane((unsigned)(v >> 32));
    return (const float*)(((unsigned long long)hi << 32) | lo); }
__device__ __forceinline__ void convert_layer(unsigned char* ws, int layer, LAS unsigned char* lds, int gw, int NGW, int wave, int lane) {
    LAS float* scr = (LAS float*)(lds + wave * 16384);
    constexpr int I_IN = 16 * 336, I_BR = 8 * 32, I_O = 16 * 32, I_UP = 16 * 128, I_DN = 64 * 32, I_G = 16 * 32, I_P = 4 * 32;
    constexpr int NIT = I_IN + 3 * I_BR + I_O + I_UP + I_DN + I_G + I_P;
    for (int it = gw; it < NIT; it += NGW) {
        int r = it;
        if (r < I_IN) { transpose_item(ldptr(lds, 2) + (size_t)layer * 1024 * NPROJ, 1024, NPROJ, (bf16*)(ws + WS_WIN), scr, r, lane); continue; } r -= I_IN;
        if (r < 3 * I_BR) { const int br = r / I_BR; transpose_item(ldptr(lds, 5 + br) + (size_t)layer * 512 * 1024, 512, 1024, (bf16*)(ws + WS_WBR) + (size_t)br * 1024 * 512, scr, r - br * I_BR, lane); continue; } r -= 3 * I_BR;
        if (r < I_O) { transpose_item(ldptr(lds, 8) + (size_t)layer * 1024 * 1024, 1024, 1024, (bf16*)(ws + WS_WOUT), scr, r, lane); continue; } r -= I_O;
        if (r < I_UP) { transpose_item(ldptr(lds, 11) + (size_t)layer * 1024 * 4096, 1024, 4096, (bf16*)(ws + WS_WUP), scr, r, lane); continue; } r -= I_UP;
        if (r < I_DN) { transpose_item(ldptr(lds, 12) + (size_t)layer * 4096 * 1024, 4096, 1024, (bf16*)(ws + WS_WDOWN), scr, r, lane); continue; } r -= I_DN;
        if (r < I_G) { transpose_item(ldptr(lds, 13) + (size_t)layer * 1024 * 1024, 1024, 1024, (bf16*)(ws + WS_WG), scr, r, lane); continue; } r -= I_G;
        transpose_item(ldptr(lds, 14) + (size_t)layer * 256 * 1024, 256, 1024, (bf16*)(ws + WS_WP), scr, r, lane);
    }
    const float* ps = ldptr(lds, 1) + (size_t)layer * MTOK * 256; bf16* pd = (bf16*)(ws + WS_PB);
    for (size_t i = (size_t)gw * 64 + lane; i < (size_t)MTOK * 256 / 8; i += (size_t)NGW * 64) {
        const f32x4 u = *(const f32x4*)(ps + i * 8), v = *(const f32x4*)(ps + i * 8 + 4);
        v4u o; o.x = pk2(u[0], u[1]); o.y = pk2(u[2], u[3]); o.z = pk2(v[0], v[1]); o.w = pk2(v[2], v[3]); *(v4u*)(pd + i * 8) = o; }
}
__device__ __forceinline__ void ln_pass(float* Y, bf16* XB, const float* g, const float* bt, int gw, int NGW, int lane) {
    for (int m = gw; m < MTOK; m += NGW) {
        f32x4* yr = (f32x4*)(Y + (size_t)m * DM) + lane;
        f32x4 v[4]; float s = 0.f;
#pragma unroll
        for (int j = 0; j < 4; ++j) { v[j] = yr[64 * j]; s += (v[j][0] + v[j][1]) + (v[j][2] + v[j][3]); }
        const float mean = wave_sum(s, lane) * (1.f / DM); float s2 = 0.f;
#pragma unroll
        for (int j = 0; j < 4; ++j) { v[j] = v[j] - mean; s2 += (v[j][0] * v[j][0] + v[j][1] * v[j][1]) + (v[j][2] * v[j][2] + v[j][3] * v[j][3]); }
        const float rstd = 1.f / sqrtf(wave_sum(s2, lane) * (1.f / DM) + 1e-5f);
        unsigned long long* o8 = (unsigned long long*)(XB + (size_t)m * DM) + lane;
#pragma unroll
        for (int j = 0; j < 4; ++j) { const f32x4 gv = ((const f32x4*)g)[lane + 64 * j], bv = ((const f32x4*)bt)[lane + 64 * j];
            const f32x4 o = v[j] * rstd * gv + bv; yr[64 * j] = o;
            o8[64 * j] = (unsigned long long)pk2(o[0], o[1]) | ((unsigned long long)pk2(o[2], o[3]) << 32); }
    }
}

__global__ void __launch_bounds__(512, 2) mk_fwd(Args a) {
    extern __shared__ __attribute__((aligned(16))) unsigned char lds_raw[];
    LAS unsigned char* lds = (LAS unsigned char*)lds_raw;
    cg::grid_group grid = cg::this_grid();
    const int tid0 = threadIdx.x;
    const int G = gridDim.x, bid0 = blockIdx.x;
    const int NGW = G * 8;
    unsigned* const barw = (unsigned*)a.ws + 1024;
    if (bid0 == 0) for (int i = tid0; i < XCD_BAR_WORDS; i += 512) __hip_atomic_store(barw + i, 0u, __ATOMIC_RELAXED, __HIP_MEMORY_SCOPE_AGENT);
    volatile LAS unsigned* const bst = (volatile LAS unsigned*)(lds + PTAB_OFF + 256);
    if (tid0 < 2) bst[tid0] = 0u;
    if (tid0 == 0) { LAS unsigned long long* pt = (LAS unsigned long long*)(lds + PTAB_OFF);
#pragma unroll
        for (int i = 0; i < 18; ++i) pt[i] = (unsigned long long)a.in[i]; }
    __syncthreads();
    { const int lane = tid0 & 63, wave = __builtin_amdgcn_readfirstlane(tid0 >> 6), gw = bid0 * 8 + wave; unsigned char* ws = a.ws; bf16* XB = (bf16*)(ws + WS_XB);
      convert_layer(ws, 0, lds, gw, NGW, wave, lane);
      const float* xs = ldptr(lds, 0);
      for (size_t i = (size_t)gw * 64 + lane; i < (size_t)MTOK * DM / 8; i += (size_t)NGW * 64) {
          const f32x4 u = *(const f32x4*)(xs + i * 8), v = *(const f32x4*)(xs + i * 8 + 4);
          v4u o; o.x = pk2(u[0], u[1]); o.y = pk2(u[2], u[3]); o.z = pk2(v[0], v[1]); o.w = pk2(v[2], v[3]); *(v4u*)(XB + i * 8) = o; } }
    grid.sync();
    const XcdBarrier xbar = xcd_barrier_post(barw, bst);
#ifdef PROBE_ATT2
    int rep = 0;
#endif
    for (int step = 0; step < NLAYER * 18; ++step) {
        const int layer = step / 18, s = step - layer * 18;
        int tid = tid0; asm volatile("" : "+v"(tid));
        const int lane = tid & 63, wave = __builtin_amdgcn_readfirstlane(tid >> 6);
        int bid = bid0; asm volatile("" : "+s"(bid));
        const int gw = bid * 8 + wave;
        unsigned char* ws = a.ws; asm volatile("" : "+s"(ws));
        float* outp = a.out; asm volatile("" : "+s"(outp));
        bf16* XB = (bf16*)(ws + WS_XB);
        int kind = 3; bool sync = true;
        pg8::Gemm g{nullptr, nullptr, 0, 0, 0};
        pg8::EpiB EB{0, (bf16*)(ws + WS_QK), (bf16*)(ws + WS_VT), (bf16*)(ws + WS_GT), (bf16*)(ws + WS_HID), MC};
        pg8::EpiF EF{0, nullptr, nullptr, outp, (const bf16*)(ws + WS_GT), (bf16*)(ws + WS_MRG), 0, 0, ALPHA};
        int chunk = 0;
        if (s < 12) {
            chunk = s / 6; const int k = s - chunk * 6;
            if (k == 0) { kind = 0; g = pg8::Gemm{XB + (size_t)chunk * MC * DM, (const bf16*)(ws + WS_WIN), MC, NPROJ, DM}; EB.mode = 0; }
            else if (k == 1) { kind = 2; }
            else if (k <= 4) { kind = 1; const int br = k - 2; sync = (k == 4);
                g = pg8::Gemm{(const bf16*)(ws + WS_ODA + (size_t)br * 16 * MiB), (const bf16*)(ws + WS_WBR) + (size_t)br * 1024 * 512, MC, DM, 512};
                EF.mode = br; EF.F = (float*)(ws + WS_MF); EF.gofs = br * 1024; }
            else { kind = 1; sync = (chunk == 1);
                g = pg8::Gemm{(const bf16*)(ws + WS_MRG), (const bf16*)(ws + WS_WOUT), MC, DM, DM};
                EF.mode = 3; EF.X = (layer == 0) ? ldptr(lds, 0) : outp; EF.rowoff = chunk * MC; }
        } else if (s == 12) { kind = 3; }
        else if (s == 13) { kind = 0; sync = false; g = pg8::Gemm{XB, (const bf16*)(ws + WS_WUP), MTOK, DFF, DM}; EB.mode = 1; }
        else if (s == 14) { kind = 1; sync = false; g = pg8::Gemm{XB, (const bf16*)(ws + WS_WG), MTOK, DM, DM}; EF.mode = 4; EF.F = (float*)(ws + WS_TMP); }
        else if (s == 15) { kind = 1; g = pg8::Gemm{(const bf16*)(ws + WS_PB), (const bf16*)(ws + WS_WP), MTOK, DM, 256}; EF.mode = 5; EF.F = (float*)(ws + WS_TMP); }
        else if (s == 16) { kind = 1; g = pg8::Gemm{(const bf16*)(ws + WS_HID), (const bf16*)(ws + WS_WDOWN), MTOK, DM, DFF}; EF.mode = 6; }
        else { kind = 4; }

#ifndef NO_GEMMB
        if (kind == 0) { pg8::StaticOrder S; S.init(g.M, g.N, G, bid); pg8::gemm_phase<pg8::EpiB, pg8::StaticOrder, true, true>(lds, g, S, EB, tid); }
#else
        if (0) {}
#endif
#ifndef NO_GEMMF
        else if (kind == 1) { pg8::StaticOrder S; S.init(g.M, g.N, G, bid); pg8::gemm_phase<pg8::EpiF, pg8::StaticOrder, true, true>(lds, g, S, EF, tid); }
#endif
#ifndef NO_ATT
        else if (kind == 2) {
            const bf16* QK = (const bf16*)(ws + WS_QK); const bf16* VT = (const bf16*)(ws + WS_VT);
            const float lam_init = 0.8f - 0.6f * expf(-0.3f * (float)layer);
#ifndef NO_A
#ifdef PROBE_A2
            for (int rep = 0; rep < 2; ++rep)
#endif
            for (int u = bid; u < 256; u += G)
                att::attnA_unit(lds, QK, VT, (bf16*)(ws + WS_ODA), MC, u >> 6, (u >> 4) & 3, u & 15, ldptr(lds, 3) + layer * 256, ldptr(lds, 4) + layer * 128, ldptr(lds, 17), lam_init, tid, wave, lane);
#endif
#ifndef NO_C
            for (int u = bid; u < 128; u += G)
                att::attnC_unit((LAS float*)(lds + 126976), QK, VT, (float*)(ws + WS_SCR), (float*)(ws + WS_LSE), (bf16*)(ws + WS_ODL), MC, u >> 5, (u >> 3) & 3, u & 7, ldptr(lds, 17), tid, wave, lane);
#endif
#ifndef NO_B
            if (G > 128) { if (bid >= 128) for (int u = bid - 128; u < 512; u += G - 128) att::attnB_unit(QK, VT, (bf16*)(ws + WS_OSB), MC, u >> 7, (u >> 4) & 7, u & 15, wave, lane); }
            else for (int u = bid; u < 512; u += G) att::attnB_unit(QK, VT, (bf16*)(ws + WS_OSB), MC, u >> 7, (u >> 4) & 7, u & 15, wave, lane);
#endif
        }
#endif
        else if (kind == 3) { ln_pass(outp, XB, ldptr(lds, 9) + layer * DM, ldptr(lds, 10) + layer * DM, gw, NGW, lane); }
        else { ln_pass(outp, XB, ldptr(lds, 15) + layer * DM, ldptr(lds, 16) + layer * DM, gw, NGW, lane);
               if (layer + 1 < NLAYER) convert_layer(ws, layer + 1, lds, gw, NGW, wave, lane); }
#ifdef PROBE_ATT2
        if (kind == 2) { if (rep == 0) { rep = 1; --step; sync = false; } else rep = 0; }
#endif
        if (sync && step + 1 < NLAYER * 18) { xcd_barrier(xbar);
#ifdef PROBE_SYNC2
            xcd_barrier(xbar);
#endif
        }
    }
}

extern "C" void kernel_launch(void* const* d_in, const int* in_sizes, int n_in, void* d_out, int out_size, void* d_ws, size_t ws_size, hipStream_t stream) {
    static int grid = 0;
    if (grid == 0) {
        if (n_in != 18 || out_size != MTOK * DM || ws_size < WS_END) { fprintf(stderr, "kernel_launch: unexpected shapes (n_in %d out %d ws %zu)\n", n_in, out_size, ws_size); grid = -1; return; }
        int dev = 0, cus = 0, per_cu = 0;
        (void)hipGetDevice(&dev); (void)hipDeviceGetAttribute(&cus, hipDeviceAttributeMultiprocessorCount, dev);
        if (hipFuncSetAttribute((const void*)mk_fwd, hipFuncAttributeMaxDynamicSharedMemorySize, LDS_BYTES) != hipSuccess) { fprintf(stderr, "hipFuncSetAttribute failed\n"); grid = -1; return; }
        if (hipOccupancyMaxActiveBlocksPerMultiprocessor(&per_cu, (const void*)mk_fwd, 512, LDS_BYTES) != hipSuccess || per_cu < 1) { fprintf(stderr, "occupancy query says %d\n", per_cu); per_cu = 1; }
        (void)hipGetLastError();
        grid = cus;
    }
    if (grid < 0) return;
    Args a{};
    for (int i = 0; i < 18; ++i) a.in[i] = (const float*)d_in[i];
    a.out = (float*)d_out; a.ws = (unsigned char*)d_ws;
    void* args[] = {&a};
    hipError_t e = hipLaunchCooperativeKernel((const void*)mk_fwd, dim3(grid), dim3(512), args, LDS_BYTES, stream);
    if (e != hipSuccess) fprintf(stderr, "cooperative launch failed: %s (grid %d)\n", hipGetErrorString(e), grid);
}
```

```cpp
#include <hip/hip_runtime.h>
#include <hip/hip_cooperative_groups.h>
#include <cstdio>
#include <cstdint>
#include <cmath>
namespace cg = cooperative_groups;
namespace pg8 {
#define PG8_LAS __attribute__((address_space(3)))
typedef unsigned short bf16_t;
typedef short bf16x8 __attribute__((ext_vector_type(8)));
typedef float f32x4 __attribute__((ext_vector_type(4)));
typedef unsigned u32x4 __attribute__((ext_vector_type(4)));
constexpr int BM = 256, BK = 64, HALF = 128, HTB = HALF * BK * 2  , STAGE_BYTES = 8 * HTB, NXCD = 8, WGM = 8;

__host__ __device__ __forceinline__ int lds_byte(int r, int c) { const int st = (r >> 4) * 2 + (c >> 5), rr = r & 15, cc = c & 31, ob = rr * 64 + cc * 2; return st * 1024 + (ob ^ (((ob >> 9) & 1) << 5)); }
__host__ __device__ __forceinline__ void stage_rc(int b, int& R, int& C) { const int st = b / 1024, sb = b % 1024, swz = sb ^ (((sb >> 9) & 1) << 5); R = (st >> 1) * 16 + swz / 64; C = (st & 1) * 32 + (swz % 64) / 2; }
__host__ __device__ __forceinline__ int perm32(int rho) { const int n = rho >> 4, i = rho & 15; return 8 * (i >> 2) + 4 * n + (i & 3); }

struct Unit { int pm, pn; };
struct Gemm { const bf16_t* A; const bf16_t* Bt; int M, N, K; };

struct StaticOrder {
    int nM, nN, nwg, G, c;
    __host__ __device__ void init(int M, int N, int G_, int c_) { nM = M / BM; nN = N / BM; nwg = nM * nN; G = G_; c = c_; }
    __host__ __device__ bool next(int i, Unit& u) const {
        const long L = (long)i * G + c; if (L >= nwg) return false;
        int wgid = (int)L; { const int q = nwg / NXCD, r = nwg % NXCD, xcd = wgid % NXCD, off = wgid / NXCD; wgid = (xcd < r ? xcd * (q + 1) : r * (q + 1) + (xcd - r) * q) + off; }
        const int nig = WGM * nN, gid = wgid / nig, fm = gid * WGM, gsz = (nM - fm) < WGM ? (nM - fm) : WGM;
        u.pm = fm + ((wgid % nig) % gsz); u.pn = (wgid % nig) / gsz; return true;
    }
    __device__ __forceinline__ void a_ready(const Unit&) const {}
    __device__ __forceinline__ void done(const Unit&) const {}
};

__device__ __forceinline__ unsigned cvt_pk_bf16(float lo, float hi) { unsigned r; asm volatile("v_cvt_pk_bf16_f32 %0, %1, %2" : "=v"(r) : "v"(lo), "v"(hi)); return r; }
typedef float f32x2 __attribute__((ext_vector_type(2)));
typedef unsigned u32x2 __attribute__((ext_vector_type(2)));
#define PGAS __attribute__((address_space(1)))
__device__ __forceinline__ float fsigmoid(float x) { return __builtin_amdgcn_rcpf(1.0f + __expf(-x)); }

struct EpiB {
    static constexpr bool PERM = true, AFTER_DRAIN = false;
    int mode; bf16_t* QK; bf16_t* VT; bf16_t* GT; bf16_t* HID; int Mc;
    __device__ __forceinline__ void operator()(const f32x4 (&acc)[2][2][4][2], const Unit& u, int wr, int wc, int fr, int fq) const {
        const int row0 = u.pm * BM + wr * 64 + fr; const int cl = wc * 32 + 8 * fq; const int pn = u.pn;
        int kind, dt;
        if (mode == 1) { kind = 3; dt = pn; }
        else if (pn < 12) { const int s = pn >> 1, o = pn & 1;
            if (s == 2) { kind = 1; dt = o; } else if (s == 5) { kind = 1; dt = 2 + o; } else { kind = 0; dt = (s < 2 ? s * 2 : (s - 1) * 2) + o; } }
        else if (pn < 24) { kind = 0; dt = 8 + (pn - 12); }
        else if (pn < 30) { kind = 1; dt = 4 + (pn - 24); }
        else { kind = 2; dt = pn - 30; }
        if (kind == 1) {
            const int ld = dt < 6 ? 0 : (dt < 8 ? 2 : 4);
#pragma unroll
            for (int ai = 0; ai < 2; ++ai)
#pragma unroll
                for (int m = 0; m < 4; ++m) {
                    const int t = row0 + ai * HALF + m * 16; const int s = t & 4095;
                    const int pt = (t & ~4095) + (s & ((1 << ld) - 1)) * (4096 >> ld) + (s >> ld);
#pragma unroll
                    for (int bj = 0; bj < 2; ++bj)
#pragma unroll
                        for (int n = 0; n < 2; ++n) { const f32x4 v = acc[ai][bj][m][n];
                            PGAS bf16_t* p = (PGAS bf16_t*)(VT + (size_t)(dt * 256 + bj * HALF + cl + 4 * n) * Mc + pt);
                            const unsigned w0 = cvt_pk_bf16(v[0], v[1]), w1 = cvt_pk_bf16(v[2], v[3]);
                            p[0] = (bf16_t)(w0 & 0xffffu); p[(size_t)Mc] = (bf16_t)(w0 >> 16); p[2 * (size_t)Mc] = (bf16_t)(w1 & 0xffffu); p[3 * (size_t)Mc] = (bf16_t)(w1 >> 16); }
                }
            return;
        }
        bf16_t* base; int ldc;
        if (kind == 0) { base = QK; ldc = 5120; } else if (kind == 2) { base = GT; ldc = 3072; } else { base = HID; ldc = 4096; }
        base += dt * 256 + cl;
#pragma unroll
        for (int ai = 0; ai < 2; ++ai)
#pragma unroll
            for (int m = 0; m < 4; ++m) { bf16_t* rowp = base + (size_t)(row0 + ai * HALF + m * 16) * ldc;
#pragma unroll
                for (int bj = 0; bj < 2; ++bj) { f32x4 v0 = acc[ai][bj][m][0], v1 = acc[ai][bj][m][1];
                    if (kind == 2) {
#pragma unroll
                        for (int e = 0; e < 4; ++e) { v0[e] = fsigmoid(v0[e]); v1[e] = fsigmoid(v1[e]); } }
                    else if (kind == 3) {
#pragma unroll
                        for (int e = 0; e < 4; ++e) { const float a = fmaxf(v0[e], 0.f), b = fmaxf(v1[e], 0.f); v0[e] = a * a; v1[e] = b * b; } }
                    u32x4 w; w.x = cvt_pk_bf16(v0[0], v0[1]); w.y = cvt_pk_bf16(v0[2], v0[3]); w.z = cvt_pk_bf16(v1[0], v1[1]); w.w = cvt_pk_bf16(v1[2], v1[3]);
                    *(PGAS u32x4*)(rowp + bj * HALF) = w; } }
    }
};

struct EpiF {
    static constexpr bool PERM = false, AFTER_DRAIN = false;
    int mode; float* F; const float* X; float* Y; const bf16_t* GT; bf16_t* OB; int gofs; int rowoff; float alpha;
    __device__ __forceinline__ void operator()(const f32x4 (&acc)[2][2][4][2], const Unit& u, int wr, int wc, int fr, int fq) const {
        const int row0 = u.pm * BM + wr * 64 + fr; const int col0 = u.pn * BM + wc * 32 + 4 * fq;
#pragma unroll
        for (int ai = 0; ai < 2; ++ai)
#pragma unroll
            for (int m = 0; m < 4; ++m) { const int row = row0 + ai * HALF + m * 16;
#pragma unroll
                for (int bj = 0; bj < 2; ++bj)
#pragma unroll
                    for (int n = 0; n < 2; ++n) { const int col = col0 + bj * HALF + n * 16; const f32x4 v = acc[ai][bj][m][n];
                        const size_t o = (size_t)row * 1024 + col;
                        if (mode <= 2) {
                            const u32x2 gw = *(const PGAS u32x2*)(GT + (size_t)row * 3072 + gofs + col);
                            f32x4 g; g[0] = __uint_as_float(gw.x << 16); g[1] = __uint_as_float(gw.x & 0xffff0000u); g[2] = __uint_as_float(gw.y << 16); g[3] = __uint_as_float(gw.y & 0xffff0000u);
                            f32x4 r = g * v;
                            if (mode >= 1) r += *(const PGAS f32x4*)(F + o);
                            if (mode <= 1) *(PGAS f32x4*)(F + o) = r;
                            else { u32x2 w; w.x = cvt_pk_bf16(r[0], r[1]); w.y = cvt_pk_bf16(r[2], r[3]); *(PGAS u32x2*)(OB + o) = w; }
                        } else if (mode == 3) {
                            const size_t og = o + (size_t)rowoff * 1024;
                            *(PGAS f32x4*)(Y + og) = *(const PGAS f32x4*)(X + og) * alpha + v;
                        } else if (mode == 4) {
                            f32x4 r; r[0] = fsigmoid(v[0]); r[1] = fsigmoid(v[1]); r[2] = fsigmoid(v[2]); r[3] = fsigmoid(v[3]);
                            *(PGAS f32x4*)(F + o) = r;
                        } else if (mode == 5) {
                            *(PGAS f32x4*)(Y + o) = *(const PGAS f32x4*)(Y + o) * alpha + *(const PGAS f32x4*)(F + o) * v;
                        } else {
                            *(PGAS f32x4*)(Y + o) = *(const PGAS f32x4*)(Y + o) + v;
                        }
                    }
                asm volatile("" ::: "memory"); }
    }
};
template <class Epi, class Sched, bool ALIGN_EPI = false, bool SP2 = false>
__device__ __forceinline__ void gemm_phase(PG8_LAS unsigned char* lds, const Gemm g, const Sched& S, const Epi& E, const int tid_in) {
    const int tid = tid_in, wid = __builtin_amdgcn_readfirstlane(tid >> 6), lane = tid & 63, wr = wid >> 2, wc = wid & 3, fr = lane & 15, fq = lane >> 4;
    const int K = g.K, nt = K / BK;
    unsigned voffA[2], voffB[2];
#pragma unroll
    for (int i = 0; i < 2; ++i) { int R, C; stage_rc(tid * 16 + i * 8192, R, C); const int Rb = Epi::PERM ? ((R & ~31) + perm32(R & 31)) : R;
        voffA[i] = (unsigned)(R * K + C) * 2u; voffB[i] = (unsigned)(Rb * K + C) * 2u; }
    const size_t kstep = (size_t)(BK * 2);
    const size_t hstep = (size_t)HALF * K * 2;
    const size_t tstep = 2 * hstep;
    const unsigned ldsw = (unsigned)wid * 1024u;
    const int aoff = lds_byte(wr * 64 + fr, fq * 8), boff = lds_byte(wc * 32 + fr, fq * 8);
#define PG8_SA(b, h) (((b) * 2 + (h)) * HTB)
#define PG8_SB(b, h) ((4 + (b) * 2 + (h)) * HTB)
#define PG8_STAGE(bufoff, gbase, voff) do { _Pragma("unroll") for (int _i = 0; _i < 2; ++_i) \
        __builtin_amdgcn_global_load_lds((const unsigned*)((const char*)(gbase) + (voff)[_i]), (PG8_LAS unsigned*)(lds + (bufoff) + ldsw + _i * 8192), 16, 0, 0); } while (0)
#define PG8_LDA(dst, b, h) do { _Pragma("unroll") for (int m = 0; m < 4; ++m) _Pragma("unroll") for (int k = 0; k < 2; ++k) dst[m][k] = *(const PG8_LAS bf16x8*)(lds + PG8_SA(b, h) + aoff + m * 2048 + k * 1024); } while (0)
#define PG8_LDB(dst, b, h) do { _Pragma("unroll") for (int n = 0; n < 2; ++n) _Pragma("unroll") for (int k = 0; k < 2; ++k) dst[n][k] = *(const PG8_LAS bf16x8*)(lds + PG8_SB(b, h) + boff + n * 2048 + k * 1024); } while (0)
#define PG8_MMA(ai, bj, At, Bt) do { __builtin_amdgcn_s_setprio(1); _Pragma("unroll") for (int m = 0; m < 4; ++m) _Pragma("unroll") for (int n = 0; n < 2; ++n) _Pragma("unroll") for (int k = 0; k < 2; ++k) \
        acc[ai][bj][m][n] = __builtin_amdgcn_mfma_f32_16x16x32_bf16(Bt[n][k], At[m][k], acc[ai][bj][m][n], 0, 0, 0); __builtin_amdgcn_s_setprio(0); } while (0)
#define PG8_WAIT_V(n) asm volatile("s_waitcnt vmcnt(" #n ")" ::: "memory")
#define PG8_WAIT_L(n) asm volatile("s_waitcnt lgkmcnt(" #n ")" ::: "memory")
#define PG8_BAR __builtin_amdgcn_s_barrier()
#define PG8_SCHED __builtin_amdgcn_sched_barrier(0)
    Unit cur, nxt; int ui = 0;
    if (!S.next(0, cur)) return;
    f32x4 acc[2][2][4][2];
#pragma unroll
    for (int a = 0; a < 2; ++a)
#pragma unroll
        for (int b = 0; b < 2; ++b)
#pragma unroll
            for (int m = 0; m < 4; ++m)
#pragma unroll
                for (int n = 0; n < 2; ++n) acc[a][b][m][n] = (f32x4){0.f, 0.f, 0.f, 0.f};
    bf16x8 At[4][2], B0[2][2], B1[2][2];
    const char* cA = (const char*)g.A + (size_t)cur.pm * tstep; const char* cB = (const char*)g.Bt + (size_t)cur.pn * tstep;
    S.a_ready(cur);
    if constexpr (SP2) {
        PG8_STAGE(PG8_SB(0, 0), cB, voffB); PG8_STAGE(PG8_SB(0, 1), cB + hstep, voffB); PG8_STAGE(PG8_SA(0, 0), cA, voffA); PG8_STAGE(PG8_SA(0, 1), cA + hstep, voffA);
        if (wr == 1) PG8_BAR;
        PG8_WAIT_V(2); PG8_BAR;
        PG8_STAGE(PG8_SB(1, 0), cB + kstep, voffB); PG8_STAGE(PG8_SA(1, 0), cA + kstep, voffA); PG8_STAGE(PG8_SB(1, 1), cB + hstep + kstep, voffB);
        PG8_WAIT_V(6); PG8_BAR;
    } else {
        PG8_STAGE(PG8_SB(0, 0), cB, voffB); PG8_STAGE(PG8_SA(0, 0), cA, voffA); PG8_STAGE(PG8_SB(0, 1), cB + hstep, voffB); PG8_STAGE(PG8_SA(0, 1), cA + hstep, voffA);
        if (wr == 1) PG8_BAR;
        PG8_WAIT_V(4); PG8_BAR;
        PG8_STAGE(PG8_SB(1, 0), cB + kstep, voffB); PG8_STAGE(PG8_SA(1, 0), cA + kstep, voffA); PG8_STAGE(PG8_SB(1, 1), cB + hstep + kstep, voffB);
        PG8_WAIT_V(6); PG8_BAR;
    }
    for (;;) {
        const bool has_next = S.next(ui + 1, nxt);
        const char* nA = has_next ? (const char*)g.A + (size_t)nxt.pm * tstep : cA; const char* nB = has_next ? (const char*)g.Bt + (size_t)nxt.pn * tstep : cB;
        for (int t = 0; t < nt; t += 2) {
            const bool last = (t == nt - 2);
            const char* a1 = cA + (size_t)(t + 1) * kstep;
            const char* a2 = last ? nA : cA + (size_t)(t + 2) * kstep; const char* b2 = last ? nB : cB + (size_t)(t + 2) * kstep;
            const char* a3 = a2 + kstep; const char* b3 = b2 + kstep;
            if (last && has_next) S.a_ready(nxt);
            if constexpr (SP2) {
            PG8_LDB(B0, 0, 0); PG8_LDB(B1, 0, 1); PG8_SCHED; PG8_LDA(At, 0, 0); PG8_STAGE(PG8_SA(1, 1), a1 + hstep, voffA);
            PG8_WAIT_V(8); PG8_WAIT_L(0); PG8_BAR; PG8_MMA(0, 0, At, B0); PG8_MMA(0, 1, At, B1); PG8_BAR; PG8_SCHED;
            PG8_LDA(At, 0, 1); PG8_STAGE(PG8_SB(0, 0), b2, voffB); PG8_STAGE(PG8_SB(0, 1), b2 + hstep, voffB); PG8_STAGE(PG8_SA(0, 0), a2, voffA);
            PG8_WAIT_V(8); PG8_WAIT_L(0); PG8_BAR; PG8_MMA(1, 0, At, B0); PG8_MMA(1, 1, At, B1); PG8_BAR; PG8_SCHED;
            PG8_LDB(B0, 1, 0); PG8_LDB(B1, 1, 1); PG8_SCHED; PG8_LDA(At, 1, 0); PG8_STAGE(PG8_SA(0, 1), a2 + hstep, voffA);
            PG8_WAIT_V(8); PG8_WAIT_L(0); PG8_BAR; PG8_MMA(0, 0, At, B0); PG8_MMA(0, 1, At, B1); PG8_BAR; PG8_SCHED;
            PG8_LDA(At, 1, 1); PG8_STAGE(PG8_SB(1, 0), b3, voffB); PG8_STAGE(PG8_SB(1, 1), b3 + hstep, voffB); PG8_STAGE(PG8_SA(1, 0), a3, voffA);
            PG8_WAIT_V(8); PG8_WAIT_L(0); PG8_BAR; PG8_MMA(1, 0, At, B0); PG8_MMA(1, 1, At, B1); PG8_BAR; PG8_SCHED;
            } else {
            PG8_LDB(B0, 0, 0); PG8_SCHED; PG8_LDA(At, 0, 0); PG8_STAGE(PG8_SA(1, 1), a1 + hstep, voffA);
            PG8_WAIT_L(8); PG8_BAR; PG8_WAIT_L(0); PG8_MMA(0, 0, At, B0); PG8_BAR; PG8_SCHED;
            PG8_LDB(B1, 0, 1); PG8_STAGE(PG8_SB(0, 0), b2, voffB);
            PG8_BAR; PG8_WAIT_L(0); PG8_MMA(0, 1, At, B1); PG8_BAR;
            PG8_LDA(At, 0, 1); PG8_STAGE(PG8_SA(0, 0), a2, voffA);
            PG8_BAR; PG8_WAIT_L(0); PG8_MMA(1, 0, At, B0); PG8_BAR; PG8_SCHED;
            PG8_STAGE(PG8_SB(0, 1), b2 + hstep, voffB);
            PG8_WAIT_V(6); PG8_BAR; PG8_MMA(1, 1, At, B1); PG8_BAR;
            PG8_LDB(B0, 1, 0); PG8_SCHED; PG8_LDA(At, 1, 0); PG8_STAGE(PG8_SA(0, 1), a2 + hstep, voffA);
            PG8_WAIT_L(8); PG8_BAR; PG8_WAIT_L(0); PG8_MMA(0, 0, At, B0); PG8_BAR; PG8_SCHED;
            PG8_LDB(B1, 1, 1); PG8_STAGE(PG8_SB(1, 0), b3, voffB);
            PG8_BAR; PG8_WAIT_L(0); PG8_MMA(0, 1, At, B1); PG8_BAR;
            PG8_LDA(At, 1, 1); PG8_STAGE(PG8_SA(1, 0), a3, voffA);
            PG8_BAR; PG8_WAIT_L(0); PG8_MMA(1, 0, At, B0); PG8_BAR; PG8_SCHED;
            PG8_STAGE(PG8_SB(1, 1), b3 + hstep, voffB);
            PG8_WAIT_V(6); PG8_BAR; PG8_MMA(1, 1, At, B1); PG8_BAR;
            }
        }
        if constexpr (ALIGN_EPI) { if (wr == 0) PG8_BAR; }
        if constexpr (!Epi::AFTER_DRAIN) { E(acc, cur, wr, wc, fr, fq); S.done(cur); }
        if (!has_next) break;
#pragma unroll
        for (int a = 0; a < 2; ++a)
#pragma unroll
            for (int b = 0; b < 2; ++b)
#pragma unroll
                for (int m = 0; m < 4; ++m)
#pragma unroll
                    for (int n = 0; n < 2; ++n) acc[a][b][m][n] = (f32x4){0.f, 0.f, 0.f, 0.f};
        cur = nxt; cA = nA; cB = nB; ++ui;
        if constexpr (ALIGN_EPI) { if (wr == 1) PG8_BAR; }
    }
    PG8_WAIT_V(0);
    if constexpr (!ALIGN_EPI) { if (wr == 0) PG8_BAR; }
    PG8_BAR;
    if constexpr (Epi::AFTER_DRAIN) { E.fused(acc, cur, wr, wc, fr, fq, lds, wid, lane); S.done(cur); }
#undef PG8_SA
#undef PG8_SB
#undef PG8_STAGE
#undef PG8_LDA
#undef PG8_LDB
#undef PG8_MMA
#undef PG8_WAIT_V
#undef PG8_WAIT_L
#undef PG8_BAR
#undef PG8_SCHED
}
}
namespace att {
#define LAS __attribute__((address_space(3)))
typedef unsigned short bf16_t;
typedef short bf16x8 __attribute__((ext_vector_type(8)));
typedef float f32x16 __attribute__((ext_vector_type(16)));
typedef float f32x4 __attribute__((ext_vector_type(4)));
typedef unsigned u32x4 __attribute__((ext_vector_type(4)));
typedef unsigned u32x2 __attribute__((ext_vector_type(2)));
constexpr float LOG2E = 1.4426950408889634f;
constexpr float NEG = -1.0e30f;
constexpr int LDQK = 5120;
__device__ __forceinline__ f32x16 mfma(bf16x8 a, bf16x8 b, f32x16 c) { return __builtin_amdgcn_mfma_f32_32x32x16_bf16(a, b, c, 0, 0, 0); }
#define GAS __attribute__((address_space(1)))
__device__ __forceinline__ bf16x8 ld16(const bf16_t* p) { return *(const GAS bf16x8*)p; }
__device__ __forceinline__ unsigned cvtpk(float lo, float hi) { typedef float f2 __attribute__((ext_vector_type(2))); typedef __bf16 b2 __attribute__((ext_vector_type(2))); f2 v = {lo, hi}; b2 b = __builtin_convertvector(v, b2); return __builtin_bit_cast(unsigned, b); }
__device__ __forceinline__ bf16x8 pack8(float a0, float a1, float a2, float a3, float a4, float a5, float a6, float a7) {
    u32x4 w; w.x = cvtpk(a0, a1); w.y = cvtpk(a2, a3); w.z = cvtpk(a4, a5); w.w = cvtpk(a6, a7); return __builtin_bit_cast(bf16x8, w); }
__device__ __forceinline__ float ex2(float x) { return __builtin_amdgcn_exp2f(x); }
__device__ __forceinline__ float lg2(float x) { return __builtin_amdgcn_logf(x); }
__device__ __forceinline__ int kperm(int m) { return ((m >> 4) << 4) | (((m >> 2) & 1) << 3) | (((m >> 3) & 1) << 2) | (m & 3); }
__device__ __forceinline__ int rel_bucket(int d) { if (d < 16) return d; const float lr = logf((float)d / 16.0f) / 4.852030263919617f; const int large = 16 + (int)(lr * 16.0f); return large < 31 ? large : 31; }
__device__ __forceinline__ float xchg32(float x, int hi) { const auto rr = __builtin_amdgcn_permlane32_swap(__float_as_uint(x), __float_as_uint(x), false, false); return __uint_as_float(hi ? rr[0] : rr[1]); }
#define KL(r, hi) (16 * ((r) >> 3) + 8 * (hi) + ((r) & 7))

#ifndef FAST1
#define FAST1 1
#endif
#ifndef FAST2
#define FAST2 1
#endif
#define A_P1_TILE(JT, KBP) do { if (2 * (JT) + hfw <= sb) { { const LAS unsigned char* kr = (KBP) + ka_off; const int dbase = qpos - (2 * (JT) + hfw) * 32 - 8 * hi; const LAS float* tp = tbl + (dbase + 32 - 23); f32x16 S[2]; _Pragma("unroll") for (int mp = 0; mp < 2; ++mp) { f32x16 s = {0.f, 0.f, 0.f, 0.f, 0.f, 0.f, 0.f, 0.f, 0.f, 0.f, 0.f, 0.f, 0.f, 0.f, 0.f, 0.f}; _Pragma("unroll") for (int st = 0; st < 4; ++st) s = mfma(*(const LAS bf16x8*)(kr + mp * 128 + st * 32), qf[mp][st], s); S[mp] = s; } float mt0 = NEG, mt1 = NEG; _Pragma("unroll") for (int r = 0; r < 16; ++r) { const int c = (r & 7) + 16 * (r >> 3); const float bb = tp[23 - c]; const bool ok = c <= dbase; const float v0 = ok ? S[0][r] * SC + bb : NEG, v1 = ok ? S[1][r] * SC + bb : NEG; S[0][r] = v0; S[1][r] = v1; mt0 = fmaxf(mt0, v0); mt1 = fmaxf(mt1, v1); } const float mn0 = fmaxf(mx[0], mt0), mn1 = fmaxf(mx[1], mt1); float a0 = 0.f, a1 = 0.f; _Pragma("unroll") for (int r = 0; r < 16; ++r) { a0 += ex2(S[0][r] - mn0); a1 += ex2(S[1][r] - mn1); } sm[0] = sm[0] * ex2(mx[0] - mn0) + a0; mx[0] = mn0; sm[1] = sm[1] * ex2(mx[1] - mn1) + a1; mx[1] = mn1; } } } while (0)
#define A_P2_TILE(JT, KBP, VBP) do { if (2 * (JT) + hfw <= sb) { { const LAS unsigned char* kr = (KBP) + ka_off; const int dbase = qpos - (2 * (JT) + hfw) * 32 - 8 * hi; const LAS float* tp = tbl + (dbase + 32 - 23); f32x16 s0v = {0.f, 0.f, 0.f, 0.f, 0.f, 0.f, 0.f, 0.f, 0.f, 0.f, 0.f, 0.f, 0.f, 0.f, 0.f, 0.f}, s1v = s0v; _Pragma("unroll") for (int st = 0; st < 4; ++st) { s0v = mfma(*(const LAS bf16x8*)(kr + st * 32), qf[0][st], s0v); s1v = mfma(*(const LAS bf16x8*)(kr + 128 + st * 32), qf[1][st], s1v); } float w[16]; _Pragma("unroll") for (int r = 0; r < 16; ++r) { const int c = (r & 7) + 16 * (r >> 3); const float bb = tp[23 - c]; const float e0 = ex2(s0v[r] * SC + (bb - Mf[0])), e1 = ex2(s1v[r] * SC + (bb - Mf[1])); w[r] = c <= dbase ? (e0 * c0 - e1 * c1) : 0.f; } const bf16x8 pb0 = pack8(w[0], w[1], w[2], w[3], w[4], w[5], w[6], w[7]), pb1 = pack8(w[8], w[9], w[10], w[11], w[12], w[13], w[14], w[15]); const LAS unsigned char* vr = (VBP) + va_off; _Pragma("unroll") for (int k = 0; k < 4; ++k) { O[k] = mfma(*(const LAS bf16x8*)(vr + k * 32 * VROW), pb0, O[k]); O[k] = mfma(*(const LAS bf16x8*)(vr + k * 32 * VROW + 32), pb1, O[k]); } } } } while (0)
constexpr int KROW = 272, VROW = 144, KBUF = 64 * KROW, VBUF = 128 * VROW;
__device__ __forceinline__ void attnA_unit(LAS unsigned char* lds, const bf16_t* QK, const bf16_t* VT, bf16_t* ODA, int Mc, int b, int h, int blk,
                                           const float* lam4, const float* normg, const float* relb, float lam_init, int tid, int wave, int lane) {
    LAS float* tbl = (LAS float*)lds;
    LAS unsigned char* Kb = lds + 16640; LAS unsigned char* Vb = lds + 16640 + 2 * KBUF;
    asm volatile("" : "+v"(tid), "+v"(lane));
    LAS float* red = (LAS float*)(lds + 129024);
    __syncthreads();
    for (int d = tid; d < 4096 + 32; d += 512) tbl[d] = d < 32 ? 0.f : relb[rel_bucket(d - 32) * 16 + h] * LOG2E;
    if (tid < 128) red[tid] = lam4[(tid & 63) + 2 * (tid & 64)] * lam4[64 + (tid & 63) + 2 * (tid & 64)];
    const int hi = lane >> 5, ql = lane & 31;
    const int sb = 4 * blk + (wave & 3), hfw = wave >> 2;
    const int qpos = sb * 32 + ql;
    const size_t tokbase = (size_t)b * 4096;
    const float SC = 0.125f * LOG2E;
    const int NT = 2 * blk + 2;
    const bf16_t* qrow = QK + (tokbase + qpos) * LDQK + h * 128 + hi * 8;
    bf16x8 qf[2][4];
#pragma unroll
    for (int mp = 0; mp < 2; ++mp)
#pragma unroll
        for (int st = 0; st < 4; ++st) qf[mp][st] = ld16(qrow + mp * 64 + st * 16);
    const bf16_t* kg = QK + (tokbase + (tid >> 4)) * LDQK + 512 + h * 128 + (tid & 15) * 8;
    const int kl_off = (tid >> 4) * KROW + (tid & 15) * 16;
    const bf16_t* vg = VT + (size_t)(h * 128 + (tid >> 3)) * Mc + tokbase + (tid & 7) * 8;
    const int vl_off = (tid >> 3) * VROW + (tid & 7) * 16;
    const int ka_off = (hfw * 32 + kperm(ql)) * KROW + hi * 16, va_off = ql * VROW + hi * 16 + hfw * 64;
    bf16x8 kp0, kp1, vp0, vp1;
    kp0 = ld16(kg); kp1 = ld16(kg + (size_t)32 * LDQK);
    *(LAS bf16x8*)(Kb + kl_off) = kp0; *(LAS bf16x8*)(Kb + kl_off + 32 * KROW) = kp1;
    __syncthreads();
    float mx[2] = {NEG, NEG}, sm[2] = {0.f, 0.f};
    bf16x8 kq0, kq1;
    { const bf16_t* g2 = kg + (size_t)64 * LDQK; kp0 = ld16(g2); kp1 = ld16(g2 + (size_t)32 * LDQK); }
    for (int jt = 0; jt < NT; jt += 2) {
        if (jt + 2 < NT) { const bf16_t* g2 = kg + (size_t)(64 * (jt + 2)) * LDQK; kq0 = ld16(g2); kq1 = ld16(g2 + (size_t)32 * LDQK); }
        A_P1_TILE(jt, Kb);
        *(LAS bf16x8*)(Kb + KBUF + kl_off) = kp0; *(LAS bf16x8*)(Kb + KBUF + kl_off + 32 * KROW) = kp1;
        __syncthreads();
        if (jt + 3 < NT) { const bf16_t* g2 = kg + (size_t)(64 * (jt + 3)) * LDQK; kp0 = ld16(g2); kp1 = ld16(g2 + (size_t)32 * LDQK); }
        A_P1_TILE(jt + 1, Kb + KBUF);
        if (jt + 2 < NT) { *(LAS bf16x8*)(Kb + kl_off) = kq0; *(LAS bf16x8*)(Kb + kl_off + 32 * KROW) = kq1; }
        __syncthreads();
    }
    float Mf[2], iL[2];
    { LAS f32x4* ex = (LAS f32x4*)(lds + 90112);
      ex[wave * 64 + lane] = (f32x4){mx[0], sm[0], mx[1], sm[1]};
      __syncthreads();
      const f32x4 pa = ex[wave * 64 + (lane ^ 32)], pb = ex[(wave ^ 4) * 64 + lane], pc = ex[(wave ^ 4) * 64 + (lane ^ 32)];
#pragma unroll
      for (int mp = 0; mp < 2; ++mp) { const float M = fmaxf(fmaxf(mx[mp], pa[2 * mp]), fmaxf(pb[2 * mp], pc[2 * mp]));
          const float L = (sm[mp] * ex2(mx[mp] - M) + pa[2 * mp + 1] * ex2(pa[2 * mp] - M)) + (pb[2 * mp + 1] * ex2(pb[2 * mp] - M) + pc[2 * mp + 1] * ex2(pc[2 * mp] - M));
          Mf[mp] = M; iL[mp] = 1.0f / L; } }
    float s0 = 0.f, s1 = 0.f;
#pragma unroll 8
    for (int i = 0; i < 64; ++i) { s0 += red[i]; s1 += red[64 + i]; }
    const float lam = expf(s0) - expf(s1) + lam_init;
    const float c0 = iL[0], c1 = lam * iL[1];
    f32x16 O[4];
#pragma unroll
    for (int k = 0; k < 4; ++k) O[k] = (f32x16){0.f, 0.f, 0.f, 0.f, 0.f, 0.f, 0.f, 0.f, 0.f, 0.f, 0.f, 0.f, 0.f, 0.f, 0.f, 0.f};
    kp0 = ld16(kg); kp1 = ld16(kg + (size_t)32 * LDQK); vp0 = ld16(vg); vp1 = ld16(vg + (size_t)64 * Mc);
    *(LAS bf16x8*)(Kb + kl_off) = kp0; *(LAS bf16x8*)(Kb + kl_off + 32 * KROW) = kp1;
    *(LAS bf16x8*)(Vb + vl_off) = vp0; *(LAS bf16x8*)(Vb + vl_off + 64 * VROW) = vp1;
    __syncthreads();
    bf16x8 vq0, vq1;
    { const bf16_t* g2 = kg + (size_t)64 * LDQK; kp0 = ld16(g2); kp1 = ld16(g2 + (size_t)32 * LDQK); const bf16_t* g3 = vg + 64; vp0 = ld16(g3); vp1 = ld16(g3 + (size_t)64 * Mc); }
    for (int jt = 0; jt < NT; jt += 2) {
        if (jt + 2 < NT) { const bf16_t* g2 = kg + (size_t)(64 * (jt + 2)) * LDQK; kq0 = ld16(g2); kq1 = ld16(g2 + (size_t)32 * LDQK);
                           const bf16_t* g3 = vg + 64 * (jt + 2); vq0 = ld16(g3); vq1 = ld16(g3 + (size_t)64 * Mc); }
        A_P2_TILE(jt, Kb, Vb);
        *(LAS bf16x8*)(Kb + KBUF + kl_off) = kp0; *(LAS bf16x8*)(Kb + KBUF + kl_off + 32 * KROW) = kp1; *(LAS bf16x8*)(Vb + VBUF + vl_off) = vp0; *(LAS bf16x8*)(Vb + VBUF + vl_off + 64 * VROW) = vp1;
        __syncthreads();
        if (jt + 3 < NT) { const bf16_t* g2 = kg + (size_t)(64 * (jt + 3)) * LDQK; kp0 = ld16(g2); kp1 = ld16(g2 + (size_t)32 * LDQK);
                           const bf16_t* g3 = vg + 64 * (jt + 3); vp0 = ld16(g3); vp1 = ld16(g3 + (size_t)64 * Mc); }
        A_P2_TILE(jt + 1, Kb + KBUF, Vb + VBUF);
        if (jt + 2 < NT) { *(LAS bf16x8*)(Kb + kl_off) = kq0; *(LAS bf16x8*)(Kb + kl_off + 32 * KROW) = kq1; *(LAS bf16x8*)(Vb + vl_off) = vq0; *(LAS bf16x8*)(Vb + vl_off + 64 * VROW) = vq1; }
        __syncthreads();
    }
    LAS f32x4* oex = (LAS f32x4*)(lds + 16640);
    if (wave >= 4) {
#pragma unroll
        for (int k = 0; k < 4; ++k)
#pragma unroll
            for (int rr = 0; rr < 4; ++rr) oex[((wave - 4) * 16 + k * 4 + rr) * 64 + lane] = (f32x4){O[k][4 * rr], O[k][4 * rr + 1], O[k][4 * rr + 2], O[k][4 * rr + 3]};
    }
    __syncthreads();
    if (wave < 4) {
#pragma unroll
        for (int k = 0; k < 4; ++k)
#pragma unroll
            for (int rr = 0; rr < 4; ++rr) { const f32x4 t = oex[(wave * 16 + k * 4 + rr) * 64 + lane];
                O[k][4 * rr] += t[0]; O[k][4 * rr + 1] += t[1]; O[k][4 * rr + 2] += t[2]; O[k][4 * rr + 3] += t[3]; }
        float ss = 0.f;
#pragma unroll
        for (int k = 0; k < 4; ++k)
#pragma unroll
            for (int r = 0; r < 16; ++r) ss += O[k][r] * O[k][r];
        ss += xchg32(ss, hi);
        const float rs = (1.0f / sqrtf(ss * (1.0f / 128.0f) + 1e-5f)) * (1.0f - lam_init);
        bf16_t* orow = ODA + (tokbase + qpos) * 512 + h * 128 + 4 * hi;
#pragma unroll
        for (int k = 0; k < 4; ++k)
#pragma unroll
            for (int rr = 0; rr < 4; ++rr) { const int dv = 32 * k + 8 * rr; const f32x4 g = *(const GAS f32x4*)(normg + dv + 4 * hi);
                u32x2 o; o.x = cvtpk(O[k][4 * rr] * rs * g[0], O[k][4 * rr + 1] * rs * g[1]); o.y = cvtpk(O[k][4 * rr + 2] * rs * g[2], O[k][4 * rr + 3] * rs * g[3]);
                *(GAS u32x2*)(orow + dv) = o; }
    }
}

__device__ __forceinline__ void attnB_unit(const bf16_t* QK, const bf16_t* VT, bf16_t* OSB, int Mc, int b, int h, int qb, int wave, int lane) {
    asm volatile("" : "+v"(lane));
    const int hi = lane >> 5, ql = lane & 31;
    const int sb = qb * 8 + wave; const int qpos = sb * 32 + ql;
    const size_t tokbase = (size_t)b * 4096;
    const float SC = 0.125f * LOG2E;
    const bf16_t* qrow = QK + (tokbase + qpos) * LDQK + 1024 + h * 64 + hi * 8;
    bf16x8 qf[4];
#pragma unroll
    for (int st = 0; st < 4; ++st) qf[st] = ld16(qrow + st * 16);
    const bf16_t* kbase = QK + (tokbase + kperm(ql)) * LDQK + 1536 + h * 64 + hi * 8;
    const bf16_t* vbase = VT + (size_t)(512 + h * 64 + ql) * Mc + tokbase + 8 * hi;
    f32x16 O[2];
#pragma unroll
    for (int k = 0; k < 2; ++k) O[k] = (f32x16){0.f, 0.f, 0.f, 0.f, 0.f, 0.f, 0.f, 0.f, 0.f, 0.f, 0.f, 0.f, 0.f, 0.f, 0.f, 0.f};
    float carry = 0.f;
    bf16x8 kf[4];
    { const bf16_t* kr = kbase + (size_t)(sb * 32) * LDQK;
#pragma unroll
      for (int st = 0; st < 4; ++st) kf[st] = ld16(kr + st * 16); }
    for (int j = sb; j >= 0; --j) {
        bf16x8 vf[4];
        { const bf16_t* vr = vbase + j * 32;
#pragma unroll
          for (int k = 0; k < 2; ++k) { vf[2 * k] = ld16(vr + (size_t)(k * 32) * Mc); vf[2 * k + 1] = ld16(vr + (size_t)(k * 32) * Mc + 16); } }
        f32x16 s = {0.f, 0.f, 0.f, 0.f, 0.f, 0.f, 0.f, 0.f, 0.f, 0.f, 0.f, 0.f, 0.f, 0.f, 0.f, 0.f};
#pragma unroll
        for (int st = 0; st < 4; ++st) s = mfma(kf[st], qf[st], s);
        if (j > 0) { const bf16_t* kr = kbase + (size_t)((j - 1) * 32) * LDQK;
#pragma unroll
            for (int st = 0; st < 4; ++st) kf[st] = ld16(kr + st * 16); }
        const int dbase = qpos - j * 32 - 8 * hi;
        float lk[16], zz[16];
#pragma unroll
        for (int r = 0; r < 16; ++r) { const int d = dbase - (r & 7) - 16 * (r >> 3); const float z2 = s[r] * SC;
            const float sp = fmaxf(z2, 0.f) + lg2(1.0f + ex2(-fabsf(z2)));
            lk[r] = d > 0 ? -sp : 0.f; zz[r] = d > 0 ? z2 : NEG; }
        float sf[16]; float T0 = 0.f, T1 = 0.f;
#pragma unroll
        for (int r = 7; r >= 0; --r) { sf[r] = T0; T0 += lk[r]; }
#pragma unroll
        for (int r = 15; r >= 8; --r) { sf[r] = T1; T1 += lk[r]; }
        const float P0 = xchg32(T0, hi), P1 = xchg32(T1, hi);
        const float add0 = carry + (hi == 0 ? (P0 + T1 + P1) : (P1 + T1));
        const float add1 = carry + (hi == 0 ? P1 : 0.f);
        float a[16];
#pragma unroll
        for (int r = 0; r < 16; ++r) a[r] = ex2(zz[r] + lk[r] + sf[r] + (r < 8 ? add0 : add1));
        const bf16x8 pb0 = pack8(a[0], a[1], a[2], a[3], a[4], a[5], a[6], a[7]), pb1 = pack8(a[8], a[9], a[10], a[11], a[12], a[13], a[14], a[15]);
#pragma unroll
        for (int k = 0; k < 2; ++k) { O[k] = mfma(vf[2 * k], pb0, O[k]); O[k] = mfma(vf[2 * k + 1], pb1, O[k]); }
        carry += (T0 + T1) + (P0 + P1);
        if (__all(carry < -160.0f)) break;
    }
    bf16_t* orow = OSB + (tokbase + qpos) * 512 + h * 64 + 4 * hi;
#pragma unroll
    for (int k = 0; k < 2; ++k)
#pragma unroll
        for (int rr = 0; rr < 4; ++rr) { u32x2 o; o.x = cvtpk(O[k][4 * rr], O[k][4 * rr + 1]); o.y = cvtpk(O[k][4 * rr + 2], O[k][4 * rr + 3]); *(GAS u32x2*)(orow + 32 * k + 8 * rr) = o; }
}

__device__ __forceinline__ void attnC_unit(LAS float* tblC, const bf16_t* QK, const bf16_t* VT, float* SCR, float* LSE, bf16_t* ODL, int Mc, int b, int hh, int R,
                                           const float* relb, int tid, int wave, int lane) {
    asm volatile("" : "+v"(tid), "+v"(lane));
    __syncthreads();
    for (int i = tid; i < 3 * 129; i += 512) { const int g = i / 129, j = i - g * 129; tblC[g * 132 + j] = relb[rel_bucket(j << (2 * g)) * 16 + 4 + g * 4 + hh] * LOG2E; }
    __syncthreads();
    const int hi = lane >> 5, ql = lane & 31;
    const size_t tokbase = (size_t)b * 4096;
    const float SC = 0.08838834764831845f * LOG2E;
#pragma unroll 1
    for (int g = 0; g < 3; ++g) {
        const int ld = 2 * g, nmb = 16 >> ld;
#pragma unroll 1
        for (int tt = 0; tt < 2; ++tt) {
            const int t = wave * 2 + tt; const int res = t / nmb, mb = t - res * nmb;
            const int m0 = R * (512 >> ld) + 32 * mb;
            const int token = ((m0 + ql) << ld) + res;
            const bf16_t* qrow = QK + (tokbase + token) * LDQK + 2048 + g * 512 + hh * 128 + hi * 8;
            bf16x8 qf[8];
#pragma unroll
            for (int st = 0; st < 8; ++st) qf[st] = ld16(qrow + st * 16);
            f32x16 O[4];
#pragma unroll
            for (int k = 0; k < 4; ++k) O[k] = (f32x16){0.f, 0.f, 0.f, 0.f, 0.f, 0.f, 0.f, 0.f, 0.f, 0.f, 0.f, 0.f, 0.f, 0.f, 0.f, 0.f};
            const bf16_t* kbase = QK + (tokbase + res) * LDQK + 3584 + g * 512 + hh * 128 + hi * 8;
            const bf16_t* vbase = VT + (size_t)(1024 + g * 512 + hh * 128 + ql) * Mc + tokbase + res * (4096 >> ld) + 8 * hi;
            const LAS float* tg = tblC + g * 132;
            float M = NEG, Ll = 0.f;
            const int jt0 = m0 >= 128 ? 0 : ((128 - m0) >> 5);
            bf16x8 kf[8];
            { const bf16_t* kr = kbase + ((size_t)(m0 - 128 + 32 * jt0 + kperm(ql)) << ld) * LDQK;
#pragma unroll
              for (int st = 0; st < 8; ++st) kf[st] = ld16(kr + st * 16); }
#pragma unroll 1
            for (int jt = jt0; jt < 5; ++jt) {
                const int mt0 = m0 - 128 + 32 * jt;
                bf16x8 vf[8];
                { const bf16_t* vr = vbase + mt0;
#pragma unroll
                  for (int k = 0; k < 4; ++k) { vf[2 * k] = ld16(vr + (size_t)(k * 32) * Mc); vf[2 * k + 1] = ld16(vr + (size_t)(k * 32) * Mc + 16); } }
                f32x16 s = {0.f, 0.f, 0.f, 0.f, 0.f, 0.f, 0.f, 0.f, 0.f, 0.f, 0.f, 0.f, 0.f, 0.f, 0.f, 0.f};
#pragma unroll
                for (int st = 0; st < 8; ++st) s = mfma(kf[st], qf[st], s);
                if (jt + 1 < 5) { const bf16_t* kr = kbase + ((size_t)(mt0 + 32 + kperm(ql)) << ld) * LDQK;
#pragma unroll
                    for (int st = 0; st < 8; ++st) kf[st] = ld16(kr + st * 16); }
                const int jb = 128 - 32 * jt + ql - 8 * hi;
                float mt = NEG;
#pragma unroll
                for (int r = 0; r < 16; ++r) { const int jd = jb - ((r & 7) + 16 * (r >> 3));
                    const bool ok = (jd >= 0) && (jd <= 128);
                    const float v = ok ? s[r] * SC + tg[jd < 0 ? 0 : (jd > 128 ? 128 : jd)] : NEG; s[r] = v; mt = fmaxf(mt, v); }
                mt = fmaxf(mt, xchg32(mt, hi));
                const float mn = fmaxf(M, mt), al = ex2(M - mn); M = mn;
                float a = 0.f;
#pragma unroll
                for (int r = 0; r < 16; ++r) { const float e = ex2(s[r] - mn); s[r] = e; a += e; }
                Ll = Ll * al + a;
#pragma unroll
                for (int k = 0; k < 4; ++k)
#pragma unroll
                    for (int r = 0; r < 16; ++r) O[k][r] *= al;
                const bf16x8 pb0 = pack8(s[0], s[1], s[2], s[3], s[4], s[5], s[6], s[7]), pb1 = pack8(s[8], s[9], s[10], s[11], s[12], s[13], s[14], s[15]);
#pragma unroll
                for (int k = 0; k < 4; ++k) { O[k] = mfma(vf[2 * k], pb0, O[k]); O[k] = mfma(vf[2 * k + 1], pb1, O[k]); }
            }
            const float L = Ll + xchg32(Ll, hi);
            { const float iL = 1.0f / L;
#pragma unroll
              for (int k = 0; k < 4; ++k)
#pragma unroll
                for (int r = 0; r < 16; ++r) O[k][r] *= iL; }
            float lse = M + lg2(L);
            float* srow = SCR + (tokbase + token) * 512 + hh * 128 + 4 * hi;
            float* lp = LSE + (tokbase + token) * 4 + hh;
            if (g > 0) {
                const float lo = *(const GAS float*)lp; const float mxl = fmaxf(lo, lse);
                const float ea = ex2(lo - mxl), eb = ex2(lse - mxl); const float inv = 1.0f / (ea + eb);
                const float wa = ea * inv, wb = eb * inv; lse = mxl + lg2(ea + eb);
#pragma unroll
                for (int k = 0; k < 4; ++k)
#pragma unroll
                    for (int rr = 0; rr < 4; ++rr) { const f32x4 old = *(const GAS f32x4*)(srow + 32 * k + 8 * rr);
#pragma unroll
                        for (int e = 0; e < 4; ++e) O[k][4 * rr + e] = wa * old[e] + wb * O[k][4 * rr + e]; }
            }
            if (g < 2) {
#pragma unroll
                for (int k = 0; k < 4; ++k)
#pragma unroll
                    for (int rr = 0; rr < 4; ++rr) *(GAS f32x4*)(srow + 32 * k + 8 * rr) = (f32x4){O[k][4 * rr], O[k][4 * rr + 1], O[k][4 * rr + 2], O[k][4 * rr + 3]};
                if (hi == 0) *(GAS float*)lp = lse;
            } else {
                bf16_t* orow = ODL + (tokbase + token) * 512 + hh * 128 + 4 * hi;
#pragma unroll
                for (int k = 0; k < 4; ++k)
#pragma unroll
                    for (int rr = 0; rr < 4; ++rr) { u32x2 o; o.x = cvtpk(O[k][4 * rr], O[k][4 * rr + 1]); o.y = cvtpk(O[k][4 * rr + 2], O[k][4 * rr + 3]); *(GAS u32x2*)(orow + 32 * k + 8 * rr) = o; }
            }
        }
        if (g < 2) __syncthreads();
    }
}
}
constexpr int MTOK = 32768, DM = 1024, DFF = 4096, NPROJ = 10752, MC = 16384, NLAYER = 4;
constexpr size_t MiB = 1u << 20;
constexpr size_t WS_WIN = 1 * MiB, WS_WBR = 22 * MiB, WS_WOUT = 25 * MiB, WS_WUP = 27 * MiB, WS_WDOWN = 35 * MiB, WS_WG = 43 * MiB, WS_WP = 45 * MiB;
constexpr size_t WS_PB = 46 * MiB, WS_XB = 62 * MiB, WS_QK = 126 * MiB, WS_VT = 286 * MiB, WS_GT = 366 * MiB, WS_HID = 126 * MiB;
constexpr size_t WS_ODA = 462 * MiB, WS_OSB = 478 * MiB, WS_ODL = 494 * MiB, WS_SCR = 510 * MiB, WS_LSE = 542 * MiB, WS_MF = 543 * MiB, WS_MRG = 607 * MiB, WS_TMP = 462 * MiB, WS_END = 639 * MiB;
constexpr int LDS_BYTES = 143360;
constexpr float ALPHA = 1.681792830507429f;
typedef unsigned short bf16;
typedef unsigned v4u __attribute__((ext_vector_type(4)));
typedef float f32x4 __attribute__((ext_vector_type(4)));
__device__ __forceinline__ unsigned pk2(float lo, float hi) { return pg8::cvt_pk_bf16(lo, hi); }
__device__ __forceinline__ float wave_sum(float v, int lane) {
#pragma unroll
    for (int o = 1; o < 64; o <<= 1) v += __int_as_float(__builtin_amdgcn_ds_bpermute((lane ^ o) << 2, __float_as_int(v)));
    return v; }
__device__ __forceinline__ void transpose_item(const float* W, int K, int N, bf16* WT, LAS float* scr, int item, int lane) {
    const int nblk = N / 32, kb = item / nblk, nb = item - kb * nblk, k0 = 64 * kb, n0 = 32 * nb;
#pragma unroll 8
    for (int i = 0; i < 32; ++i) { const int kk = 2 * i + (lane >> 5); scr[kk * 33 + (lane & 31)] = ((const GAS float*)W)[(size_t)(k0 + kk) * N + n0 + (lane & 31)]; }
    asm volatile("s_waitcnt lgkmcnt(0)" ::: "memory");
    const int c = lane & 7;
#pragma unroll
    for (int j = 0; j < 4; ++j) { const int n = (lane >> 3) + 8 * j; const LAS float* s = scr + (8 * c) * 33 + n;
        v4u o; o.x = pk2(s[0 * 33], s[1 * 33]); o.y = pk2(s[2 * 33], s[3 * 33]); o.z = pk2(s[4 * 33], s[5 * 33]); o.w = pk2(s[6 * 33], s[7 * 33]);
        *(GAS v4u*)(WT + (size_t)(n0 + n) * K + k0 + 8 * c) = o; }
    asm volatile("s_waitcnt lgkmcnt(0)" ::: "memory");
}
#define XB_TMO      128
#define XB_XCNT(j)  (256  + 64 * (j))
#define XB_XSUB(j)  (1280 + 64 * (j))
#define XB_XGEN(j)  (2304 + 64 * (j))
#define XB_TOP      3328
#define XB_TOPGEN   3392
#define XCD_BAR_WORDS 3456
#define XB_SPIN_CAP (1u << 18)

__device__ __forceinline__ unsigned xb_ld(unsigned* p)              { return __hip_atomic_load(p, __ATOMIC_RELAXED, __HIP_MEMORY_SCOPE_AGENT); }
__device__ __forceinline__ unsigned xb_add(unsigned* p, unsigned v) { return __hip_atomic_fetch_add(p, v, __ATOMIC_RELAXED, __HIP_MEMORY_SCOPE_AGENT); }
__device__ __forceinline__ unsigned xb_xcc_id() { return (unsigned)__builtin_amdgcn_s_getreg((3 << 11) | 20) & 0xFu; }
#define XB_SPIN(cond, bar) do { unsigned _sp = 0; while (cond) { __builtin_amdgcn_s_sleep(1); \
    if ((++_sp & 255u) == 0u) { if (xb_ld(&(bar)[XB_TMO])) break; if (_sp > XB_SPIN_CAP) { atomicAdd(&(bar)[XB_TMO], 1u); break; } } } } while (0)

struct XcdBarrier {
    unsigned* bar; unsigned x;
    volatile LAS unsigned* st;
};

__device__ __forceinline__ XcdBarrier xcd_barrier_post(unsigned* bar, volatile LAS unsigned* st) {
    XcdBarrier b; b.bar = bar; b.x = xb_xcc_id(); b.st = st;
    if (threadIdx.x == 0) (void)xb_add(&bar[XB_XCNT(b.x)], 1u);
    return b;
}
__device__ __forceinline__ void xcd_barrier_complete(unsigned* bar, unsigned x, unsigned& nloc, unsigned& nx) {
    const unsigned G = gridDim.x * gridDim.y * gridDim.z;
    unsigned sum, cnt, mine, sp = 0u;
    for (;;) {
        sum = 0u; cnt = 0u; mine = 0u;
#pragma unroll
        for (unsigned j = 0; j < 16; ++j) { const unsigned c = xb_ld(&bar[XB_XCNT(j)]); sum += c; cnt += (c > 0u) ? 1u : 0u; mine = (j == x) ? c : mine; }
        if (sum == G) break;
        __builtin_amdgcn_s_sleep(1);
        if ((++sp & 255u) == 0u) { if (xb_ld(&bar[XB_TMO])) break; if (sp > XB_SPIN_CAP) { atomicAdd(&bar[XB_TMO], 1u); break; } }
    }
    nloc = mine > 0u ? mine : 1u; nx = cnt > 0u ? cnt : 1u;
}

__device__ __forceinline__ void xcd_barrier(const XcdBarrier& b) {
    asm volatile("s_waitcnt vmcnt(0)" ::: "memory");
    __syncthreads();
    if (threadIdx.x == 0) {
        unsigned* bar = b.bar;
        __builtin_amdgcn_s_waitcnt(0);
        unsigned nloc = b.st[0], nx = b.st[1];
        if (nloc == 0u) { xcd_barrier_complete(bar, b.x, nloc, nx); b.st[0] = nloc; b.st[1] = nx; }
        const unsigned old = xb_add(&bar[XB_XSUB(b.x)], 1u);
        const unsigned gen = old / nloc;
        if (old + 1u == (gen + 1u) * nloc) {
            __builtin_amdgcn_fence(__ATOMIC_RELEASE, "agent");
            asm volatile("s_waitcnt vmcnt(0)" ::: "memory");
            const unsigned og = xb_add(&bar[XB_TOP], 1u);
            const unsigned tg = og / nx;
            if (og + 1u == (tg + 1u) * nx) xb_add(&bar[XB_TOPGEN], 1u);
            else XB_SPIN(xb_ld(&bar[XB_TOPGEN]) == tg, bar);
            __builtin_amdgcn_fence(__ATOMIC_ACQUIRE, "agent");
            xb_add(&bar[XB_XGEN(b.x)], 1u);
            asm volatile("s_waitcnt vmcnt(0)" ::: "memory");
        } else {
            XB_SPIN(xb_ld(&bar[XB_XGEN(b.x)]) == gen, bar);
            __builtin_amdgcn_fence(__ATOMIC_ACQUIRE, "agent");
            asm volatile("s_waitcnt vmcnt(0)" ::: "memory");
        }
    }
    __syncthreads();
}

struct Args { const float* in[18]; float* out; unsigned char* ws; };
constexpr int PTAB_OFF = 131072 + 4096;
__device__ __forceinline__ const float* ldptr(LAS unsigned char* lds, int i) {
    const unsigned long long v = ((LAS unsigned long long*)(lds + PTAB_OFF))[i];
    const unsigned lo = __builtin_amdgcn_readfirstlane((unsigned)v), hi = __builtin_amdgcn_readfirstlane((unsigned)(v >> 32));
    return (const float*)(const GAS float*)(((unsigned long long)hi << 32) | lo); }
__device__ __forceinline__ void convert_layer(unsigned char* ws, int layer, LAS unsigned char* lds, int gw, int NGW, int wave, int lane) {
    LAS float* scr = (LAS float*)(lds + wave * 16384);
    constexpr int I_IN = 16 * 336, I_BR = 8 * 32, I_O = 16 * 32, I_UP = 16 * 128, I_DN = 64 * 32, I_G = 16 * 32, I_P = 4 * 32;
    constexpr int NIT = I_IN + 3 * I_BR + I_O + I_UP + I_DN + I_G + I_P;
    for (int it = gw; it < NIT; it += NGW) {
        int r = it;
        if (r < I_IN) { transpose_item(ldptr(lds, 2) + (size_t)layer * 1024 * NPROJ, 1024, NPROJ, (bf16*)(ws + WS_WIN), scr, r, lane); continue; } r -= I_IN;
        if (r < 3 * I_BR) { const int br = r / I_BR; transpose_item(ldptr(lds, 5 + br) + (size_t)layer * 512 * 1024, 512, 1024, (bf16*)(ws + WS_WBR) + (size_t)br * 1024 * 512, scr, r - br * I_BR, lane); continue; } r -= 3 * I_BR;
        if (r < I_O) { transpose_item(ldptr(lds, 8) + (size_t)layer * 1024 * 1024, 1024, 1024, (bf16*)(ws + WS_WOUT), scr, r, lane); continue; } r -= I_O;
        if (r < I_UP) { transpose_item(ldptr(lds, 11) + (size_t)layer * 1024 * 4096, 1024, 4096, (bf16*)(ws + WS_WUP), scr, r, lane); continue; } r -= I_UP;
        if (r < I_DN) { transpose_item(ldptr(lds, 12) + (size_t)layer * 4096 * 1024, 4096, 1024, (bf16*)(ws + WS_WDOWN), scr, r, lane); continue; } r -= I_DN;
        if (r < I_G) { transpose_item(ldptr(lds, 13) + (size_t)layer * 1024 * 1024, 1024, 1024, (bf16*)(ws + WS_WG), scr, r, lane); continue; } r -= I_G;
        transpose_item(ldptr(lds, 14) + (size_t)layer * 256 * 1024, 256, 1024, (bf16*)(ws + WS_WP), scr, r, lane);
    }
    const float* ps = ldptr(lds, 1) + (size_t)layer * MTOK * 256; bf16* pd = (bf16*)(ws + WS_PB);
    for (size_t i = (size_t)gw * 64 + lane; i < (size_t)MTOK * 256 / 8; i += (size_t)NGW * 64) {
        const f32x4 u = *(const GAS f32x4*)(ps + i * 8), v = *(const GAS f32x4*)(ps + i * 8 + 4);
        v4u o; o.x = pk2(u[0], u[1]); o.y = pk2(u[2], u[3]); o.z = pk2(v[0], v[1]); o.w = pk2(v[2], v[3]); *(GAS v4u*)(pd + i * 8) = o; }
}
__device__ __forceinline__ void ln_pass(float* Y, bf16* XB, const float* g, const float* bt, int gw, int NGW, int lane) {
    for (int m = gw; m < MTOK; m += NGW) {
        GAS f32x4* yr = (GAS f32x4*)(Y + (size_t)m * DM) + lane;
        f32x4 v[4]; float s = 0.f;
#pragma unroll
        for (int j = 0; j < 4; ++j) { v[j] = yr[64 * j]; s += (v[j][0] + v[j][1]) + (v[j][2] + v[j][3]); }
        const float mean = wave_sum(s, lane) * (1.f / DM); float s2 = 0.f;
#pragma unroll
        for (int j = 0; j < 4; ++j) { v[j] = v[j] - mean; s2 += (v[j][0] * v[j][0] + v[j][1] * v[j][1]) + (v[j][2] * v[j][2] + v[j][3] * v[j][3]); }
        const float rstd = 1.f / sqrtf(wave_sum(s2, lane) * (1.f / DM) + 1e-5f);
        GAS unsigned long long* o8 = (GAS unsigned long long*)(XB + (size_t)m * DM) + lane;
#pragma unroll
        for (int j = 0; j < 4; ++j) { const f32x4 gv = ((const GAS f32x4*)g)[lane + 64 * j], bv = ((const GAS f32x4*)bt)[lane + 64 * j];
            const f32x4 o = v[j] * rstd * gv + bv; yr[64 * j] = o;
            o8[64 * j] = (unsigned long long)pk2(o[0], o[1]) | ((unsigned long long)pk2(o[2], o[3]) << 32); }
    }
}

__global__ void __launch_bounds__(512, 2) mk_fwd(Args a) {
    extern __shared__ __attribute__((aligned(16))) unsigned char lds_raw[];
    LAS unsigned char* lds = (LAS unsigned char*)lds_raw;
    cg::grid_group grid = cg::this_grid();
    const int tid0 = threadIdx.x;
    const int G = gridDim.x, bid0 = blockIdx.x;
    const int NGW = G * 8;
    unsigned* const barw = (unsigned*)a.ws + 1024;
    if (bid0 == 0) for (int i = tid0; i < XCD_BAR_WORDS; i += 512) __hip_atomic_store(barw + i, 0u, __ATOMIC_RELAXED, __HIP_MEMORY_SCOPE_AGENT);
    volatile LAS unsigned* const bst = (volatile LAS unsigned*)(lds + PTAB_OFF + 256);
    if (tid0 < 2) bst[tid0] = 0u;
    if (tid0 == 0) { LAS unsigned long long* pt = (LAS unsigned long long*)(lds + PTAB_OFF);
#pragma unroll
        for (int i = 0; i < 18; ++i) pt[i] = (unsigned long long)a.in[i]; }
    __syncthreads();
    { const int lane = tid0 & 63, wave = __builtin_amdgcn_readfirstlane(tid0 >> 6), gw = bid0 * 8 + wave; unsigned char* ws = a.ws; bf16* XB = (bf16*)(ws + WS_XB);
      convert_layer(ws, 0, lds, gw, NGW, wave, lane);
      const float* xs = ldptr(lds, 0);
      for (size_t i = (size_t)gw * 64 + lane; i < (size_t)MTOK * DM / 8; i += (size_t)NGW * 64) {
          const f32x4 u = *(const GAS f32x4*)(xs + i * 8), v = *(const GAS f32x4*)(xs + i * 8 + 4);
          v4u o; o.x = pk2(u[0], u[1]); o.y = pk2(u[2], u[3]); o.z = pk2(v[0], v[1]); o.w = pk2(v[2], v[3]); *(GAS v4u*)(XB + i * 8) = o; } }
    grid.sync();
    const XcdBarrier xbar = xcd_barrier_post(barw, bst);
#if defined(PROBE_ATT2) || defined(PROBE_GEMM2)
    int rep = 0;
#endif
    for (int step = 0; step < NLAYER * 18; ++step) {
        const int layer = step / 18, s = step - layer * 18;
        int tid = tid0; asm volatile("" : "+v"(tid));
        const int lane = tid & 63, wave = __builtin_amdgcn_readfirstlane(tid >> 6);
        int bid = bid0; asm volatile("" : "+s"(bid));
        const int gw = bid * 8 + wave;
        unsigned char* ws_ = a.ws; asm volatile("" : "+s"(ws_));
        float* outp_ = a.out; asm volatile("" : "+s"(outp_));
        unsigned char* ws = (unsigned char*)(GAS unsigned char*)ws_;
        float* outp = (float*)(GAS float*)outp_;
        bf16* XB = (bf16*)(ws + WS_XB);
        int kind = 3; bool sync = true;
        pg8::Gemm g{nullptr, nullptr, 0, 0, 0};
        pg8::EpiB EB{0, (bf16*)(ws + WS_QK), (bf16*)(ws + WS_VT), (bf16*)(ws + WS_GT), (bf16*)(ws + WS_HID), MC};
        pg8::EpiF EF{0, nullptr, nullptr, outp, (const bf16*)(ws + WS_GT), (bf16*)(ws + WS_MRG), 0, 0, ALPHA};
        int chunk = 0;
        if (s < 12) {
            chunk = s / 6; const int k = s - chunk * 6;
            if (k == 0) { kind = 0; g = pg8::Gemm{XB + (size_t)chunk * MC * DM, (const bf16*)(ws + WS_WIN), MC, NPROJ, DM}; EB.mode = 0; }
            else if (k == 1) { kind = 2; }
            else if (k <= 4) { kind = 1; const int br = k - 2; sync = (k == 4);
                g = pg8::Gemm{(const bf16*)(ws + WS_ODA + (size_t)br * 16 * MiB), (const bf16*)(ws + WS_WBR) + (size_t)br * 1024 * 512, MC, DM, 512};
                EF.mode = br; EF.F = (float*)(ws + WS_MF); EF.gofs = br * 1024; }
            else { kind = 1; sync = (chunk == 1);
                g = pg8::Gemm{(const bf16*)(ws + WS_MRG), (const bf16*)(ws + WS_WOUT), MC, DM, DM};
                EF.mode = 3; EF.X = (layer == 0) ? ldptr(lds, 0) : outp; EF.rowoff = chunk * MC; }
        } else if (s == 12) { kind = 3; }
        else if (s == 13) { kind = 0; sync = false; g = pg8::Gemm{XB, (const bf16*)(ws + WS_WUP), MTOK, DFF, DM}; EB.mode = 1; }
        else if (s == 14) { kind = 1; sync = false; g = pg8::Gemm{XB, (const bf16*)(ws + WS_WG), MTOK, DM, DM}; EF.mode = 4; EF.F = (float*)(ws + WS_TMP); }
        else if (s == 15) { kind = 1; g = pg8::Gemm{(const bf16*)(ws + WS_PB), (const bf16*)(ws + WS_WP), MTOK, DM, 256}; EF.mode = 5; EF.F = (float*)(ws + WS_TMP); }
        else if (s == 16) { kind = 1; g = pg8::Gemm{(const bf16*)(ws + WS_HID), (const bf16*)(ws + WS_WDOWN), MTOK, DM, DFF}; EF.mode = 6; }
        else { kind = 4; }

#ifndef NO_GEMMB
        if (kind == 0) { pg8::StaticOrder S; S.init(g.M, g.N, G, bid); pg8::gemm_phase<pg8::EpiB, pg8::StaticOrder, true, true>(lds, g, S, EB, tid); }
#else
        if (0) {}
#endif
#ifndef NO_GEMMF
        else if (kind == 1) { pg8::StaticOrder S; S.init(g.M, g.N, G, bid); pg8::gemm_phase<pg8::EpiF, pg8::StaticOrder, true, true>(lds, g, S, EF, tid); }
#endif
#ifndef NO_ATT
        else if (kind == 2) {
            const bf16* QK = (const bf16*)(ws + WS_QK); const bf16* VT = (const bf16*)(ws + WS_VT);
            const float lam_init = 0.8f - 0.6f * expf(-0.3f * (float)layer);
#ifndef NO_A
#ifdef PROBE_A2
            for (int rep = 0; rep < 2; ++rep)
#endif
            for (int u = bid; u < 512; u += G) {
                const int v = u & 255, p = v & 15, blk = (u < 256) ? p : 31 - p;
                att::attnA_unit(lds, QK, VT, (bf16*)(ws + WS_ODA), MC, v >> 6, (v >> 4) & 3, blk, ldptr(lds, 3) + layer * 256, ldptr(lds, 4) + layer * 128, ldptr(lds, 17), lam_init, tid, wave, lane); }
#endif
#ifndef NO_C
            for (int u = bid; u < 128; u += G)
                att::attnC_unit((LAS float*)(lds + 126976), QK, VT, (float*)(ws + WS_SCR), (float*)(ws + WS_LSE), (bf16*)(ws + WS_ODL), MC, u >> 5, (u >> 3) & 3, u & 7, ldptr(lds, 17), tid, wave, lane);
#endif
#ifndef NO_B
            if (G > 128) { if (bid >= 128) for (int u = bid - 128; u < 512; u += G - 128) att::attnB_unit(QK, VT, (bf16*)(ws + WS_OSB), MC, u >> 7, (u >> 4) & 7, u & 15, wave, lane); }
            else for (int u = bid; u < 512; u += G) att::attnB_unit(QK, VT, (bf16*)(ws + WS_OSB), MC, u >> 7, (u >> 4) & 7, u & 15, wave, lane);
#endif
        }
#endif
        else if (kind == 3) { ln_pass(outp, XB, ldptr(lds, 9) + layer * DM, ldptr(lds, 10) + layer * DM, gw, NGW, lane); }
        else { ln_pass(outp, XB, ldptr(lds, 15) + layer * DM, ldptr(lds, 16) + layer * DM, gw, NGW, lane);
               if (layer + 1 < NLAYER) convert_layer(ws, layer + 1, lds, gw, NGW, wave, lane); }
#ifdef PROBE_ATT2
        if (kind == 2) { if (rep == 0) { rep = 1; --step; sync = false; } else rep = 0; }
#endif
#ifdef PROBE_GEMM2
        if (kind == 0) { if (rep == 0) { rep = 1; --step; sync = false; } else rep = 0; }
#endif
        if (sync && step + 1 < NLAYER * 18) { xcd_barrier(xbar);
#ifdef PROBE_SYNC2
            xcd_barrier(xbar);
#endif
        }
    }
}

extern "C" void kernel_launch(void* const* d_in, const int* in_sizes, int n_in, void* d_out, int out_size, void* d_ws, size_t ws_size, hipStream_t stream) {
    static int grid = 0;
    if (grid == 0) {
        if (n_in != 18 || out_size != MTOK * DM || ws_size < WS_END) { fprintf(stderr, "kernel_launch: unexpected shapes (n_in %d out %d ws %zu)\n", n_in, out_size, ws_size); grid = -1; return; }
        int dev = 0, cus = 0, per_cu = 0;
        (void)hipGetDevice(&dev); (void)hipDeviceGetAttribute(&cus, hipDeviceAttributeMultiprocessorCount, dev);
        if (hipFuncSetAttribute((const void*)mk_fwd, hipFuncAttributeMaxDynamicSharedMemorySize, LDS_BYTES) != hipSuccess) { fprintf(stderr, "hipFuncSetAttribute failed\n"); grid = -1; return; }
        if (hipOccupancyMaxActiveBlocksPerMultiprocessor(&per_cu, (const void*)mk_fwd, 512, LDS_BYTES) != hipSuccess || per_cu < 1) { fprintf(stderr, "occupancy query says %d\n", per_cu); per_cu = 1; }
        (void)hipGetLastError();
        grid = cus;
    }
    if (grid < 0) return;
    Args a{};
    for (int i = 0; i < 18; ++i) a.in[i] = (const float*)d_in[i];
    a.out = (float*)d_out; a.ws = (unsigned char*)d_ws;
    void* args[] = {&a};
    hipError_t e = hipLaunchCooperativeKernel((const void*)mk_fwd, dim3(grid), dim3(512), args, LDS_BYTES, stream);
    if (e != hipSuccess) fprintf(stderr, "cooperative launch failed: %s (grid %d)\n", hipGetErrorString(e), grid);
}
```

```cpp
#include <hip/hip_runtime.h>
#include <hip/hip_cooperative_groups.h>
#include <cstdio>
#include <cstdint>
#include <cmath>
namespace cg = cooperative_groups;
namespace pg8 {
#define PG8_LAS __attribute__((address_space(3)))
typedef unsigned short bf16_t;
typedef short bf16x8 __attribute__((ext_vector_type(8)));
typedef float f32x4 __attribute__((ext_vector_type(4)));
typedef unsigned u32x4 __attribute__((ext_vector_type(4)));
constexpr int BM = 256, BK = 64, HALF = 128, HTB = HALF * BK * 2  , STAGE_BYTES = 8 * HTB, NXCD = 8, WGM = 8;

__host__ __device__ __forceinline__ int lds_byte(int r, int c) { const int st = (r >> 4) * 2 + (c >> 5), rr = r & 15, cc = c & 31, ob = rr * 64 + cc * 2; return st * 1024 + (ob ^ (((ob >> 9) & 1) << 5)); }
__host__ __device__ __forceinline__ void stage_rc(int b, int& R, int& C) { const int st = b / 1024, sb = b % 1024, swz = sb ^ (((sb >> 9) & 1) << 5); R = (st >> 1) * 16 + swz / 64; C = (st & 1) * 32 + (swz % 64) / 2; }
__host__ __device__ __forceinline__ int perm32(int rho) { const int n = rho >> 4, i = rho & 15; return 8 * (i >> 2) + 4 * n + (i & 3); }

struct Unit { int pm, pn; };
struct Gemm { const bf16_t* A; const bf16_t* Bt; int M, N, K; };

struct StaticOrder {
    int nM, nN, nwg, G, c;
    __host__ __device__ void init(int M, int N, int G_, int c_) { nM = M / BM; nN = N / BM; nwg = nM * nN; G = G_; c = c_; }
    __host__ __device__ bool next(int i, Unit& u) const {
        const long L = (long)i * G + c; if (L >= nwg) return false;
        int wgid = (int)L; { const int q = nwg / NXCD, r = nwg % NXCD, xcd = wgid % NXCD, off = wgid / NXCD; wgid = (xcd < r ? xcd * (q + 1) : r * (q + 1) + (xcd - r) * q) + off; }
        const int nig = WGM * nN, gid = wgid / nig, fm = gid * WGM, gsz = (nM - fm) < WGM ? (nM - fm) : WGM;
        u.pm = fm + ((wgid % nig) % gsz); u.pn = (wgid % nig) / gsz; return true;
    }
    __device__ __forceinline__ void a_ready(const Unit&) const {}
    __device__ __forceinline__ void done(const Unit&) const {}
};

__device__ __forceinline__ unsigned cvt_pk_bf16(float lo, float hi) { unsigned r; asm volatile("v_cvt_pk_bf16_f32 %0, %1, %2" : "=v"(r) : "v"(lo), "v"(hi)); return r; }
typedef float f32x2 __attribute__((ext_vector_type(2)));
typedef unsigned u32x2 __attribute__((ext_vector_type(2)));
#define PGAS __attribute__((address_space(1)))
__device__ __forceinline__ float fsigmoid(float x) { return __builtin_amdgcn_rcpf(1.0f + __expf(-x)); }

struct EpiB {
    static constexpr bool PERM = true, AFTER_DRAIN = false;
    int mode; bf16_t* QK; bf16_t* VT; bf16_t* GT; bf16_t* HID; int Mc;
    __device__ __forceinline__ void operator()(const f32x4 (&acc)[2][2][4][2], const Unit& u, int wr, int wc, int fr, int fq) const {
        const int row0 = u.pm * BM + wr * 64 + fr; const int cl = wc * 32 + 8 * fq; const int pn = u.pn;
        int kind, dt;
        if (mode == 1) { kind = 3; dt = pn; }
        else if (pn < 12) { const int s = pn >> 1, o = pn & 1;
            if (s == 2) { kind = 1; dt = o; } else if (s == 5) { kind = 1; dt = 2 + o; } else { kind = 0; dt = (s < 2 ? s * 2 : (s - 1) * 2) + o; } }
        else if (pn < 24) { kind = 0; dt = 8 + (pn - 12); }
        else if (pn < 30) { kind = 1; dt = 4 + (pn - 24); }
        else { kind = 2; dt = pn - 30; }
        if (kind == 1) {
            const int ld = dt < 6 ? 0 : (dt < 8 ? 2 : 4);
#pragma unroll
            for (int ai = 0; ai < 2; ++ai)
#pragma unroll
                for (int m = 0; m < 4; ++m) {
                    const int t = row0 + ai * HALF + m * 16; const int s = t & 4095;
                    const int pt = (t & ~4095) + (s & ((1 << ld) - 1)) * (4096 >> ld) + (s >> ld);
#pragma unroll
                    for (int bj = 0; bj < 2; ++bj)
#pragma unroll
                        for (int n = 0; n < 2; ++n) { const f32x4 v = acc[ai][bj][m][n];
                            PGAS bf16_t* p = (PGAS bf16_t*)(VT + (size_t)(dt * 256 + bj * HALF + cl + 4 * n) * Mc + pt);
                            const unsigned w0 = cvt_pk_bf16(v[0], v[1]), w1 = cvt_pk_bf16(v[2], v[3]);
                            p[0] = (bf16_t)(w0 & 0xffffu); p[(size_t)Mc] = (bf16_t)(w0 >> 16); p[2 * (size_t)Mc] = (bf16_t)(w1 & 0xffffu); p[3 * (size_t)Mc] = (bf16_t)(w1 >> 16); }
                }
            return;
        }
        bf16_t* base; int ldc;
        if (kind == 0) { base = QK; ldc = 5120; } else if (kind == 2) { base = GT; ldc = 3072; } else { base = HID; ldc = 4096; }
        base += dt * 256 + cl;
#pragma unroll
        for (int ai = 0; ai < 2; ++ai)
#pragma unroll
            for (int m = 0; m < 4; ++m) { bf16_t* rowp = base + (size_t)(row0 + ai * HALF + m * 16) * ldc;
#pragma unroll
                for (int bj = 0; bj < 2; ++bj) { f32x4 v0 = acc[ai][bj][m][0], v1 = acc[ai][bj][m][1];
                    if (kind == 2) {
#pragma unroll
                        for (int e = 0; e < 4; ++e) { v0[e] = fsigmoid(v0[e]); v1[e] = fsigmoid(v1[e]); } }
                    else if (kind == 3) {
#pragma unroll
                        for (int e = 0; e < 4; ++e) { const float a = fmaxf(v0[e], 0.f), b = fmaxf(v1[e], 0.f); v0[e] = a * a; v1[e] = b * b; } }
                    u32x4 w; w.x = cvt_pk_bf16(v0[0], v0[1]); w.y = cvt_pk_bf16(v0[2], v0[3]); w.z = cvt_pk_bf16(v1[0], v1[1]); w.w = cvt_pk_bf16(v1[2], v1[3]);
                    *(PGAS u32x4*)(rowp + bj * HALF) = w; } }
    }
};

struct EpiF {
    static constexpr bool PERM = false, AFTER_DRAIN = false;
    int mode; float* F; const float* X; float* Y; const bf16_t* GT; bf16_t* OB; int gofs; int rowoff; float alpha;
    __device__ __forceinline__ void operator()(const f32x4 (&acc)[2][2][4][2], const Unit& u, int wr, int wc, int fr, int fq) const {
        const int row0 = u.pm * BM + wr * 64 + fr; const int col0 = u.pn * BM + wc * 32 + 4 * fq;
#pragma unroll
        for (int ai = 0; ai < 2; ++ai)
#pragma unroll
            for (int m = 0; m < 4; ++m) { const int row = row0 + ai * HALF + m * 16;
#pragma unroll
                for (int bj = 0; bj < 2; ++bj)
#pragma unroll
                    for (int n = 0; n < 2; ++n) { const int col = col0 + bj * HALF + n * 16; const f32x4 v = acc[ai][bj][m][n];
                        const size_t o = (size_t)row * 1024 + col;
                        if (mode <= 2) {
                            const u32x2 gw = *(const PGAS u32x2*)(GT + (size_t)row * 3072 + gofs + col);
                            f32x4 g; g[0] = __uint_as_float(gw.x << 16); g[1] = __uint_as_float(gw.x & 0xffff0000u); g[2] = __uint_as_float(gw.y << 16); g[3] = __uint_as_float(gw.y & 0xffff0000u);
                            f32x4 r = g * v;
                            if (mode >= 1) r += *(const PGAS f32x4*)(F + o);
                            if (mode <= 1) *(PGAS f32x4*)(F + o) = r;
                            else { u32x2 w; w.x = cvt_pk_bf16(r[0], r[1]); w.y = cvt_pk_bf16(r[2], r[3]); *(PGAS u32x2*)(OB + o) = w; }
                        } else if (mode == 3) {
                            const size_t og = o + (size_t)rowoff * 1024;
                            *(PGAS f32x4*)(Y + og) = *(const PGAS f32x4*)(X + og) * alpha + v;
                        } else if (mode == 4) {
                            f32x4 r; r[0] = fsigmoid(v[0]); r[1] = fsigmoid(v[1]); r[2] = fsigmoid(v[2]); r[3] = fsigmoid(v[3]);
                            *(PGAS f32x4*)(F + o) = r;
                        } else if (mode == 5) {
                            *(PGAS f32x4*)(Y + o) = *(const PGAS f32x4*)(Y + o) * alpha + *(const PGAS f32x4*)(F + o) * v;
                        } else {
                            *(PGAS f32x4*)(Y + o) = *(const PGAS f32x4*)(Y + o) + v;
                        }
                    }
                asm volatile("" ::: "memory"); }
    }
};
template <class Epi, class Sched, bool ALIGN_EPI = false, bool SP2 = false>
__device__ __forceinline__ void gemm_phase(PG8_LAS unsigned char* lds, const Gemm g, const Sched& S, const Epi& E, const int tid_in) {
    const int tid = tid_in, wid = __builtin_amdgcn_readfirstlane(tid >> 6), lane = tid & 63, wr = wid >> 2, wc = wid & 3, fr = lane & 15, fq = lane >> 4;
    const int K = g.K, nt = K / BK;
    unsigned voffA[2], voffB[2];
#pragma unroll
    for (int i = 0; i < 2; ++i) { int R, C; stage_rc(tid * 16 + i * 8192, R, C); const int Rb = Epi::PERM ? ((R & ~31) + perm32(R & 31)) : R;
        voffA[i] = (unsigned)(R * K + C) * 2u; voffB[i] = (unsigned)(Rb * K + C) * 2u; }
    const size_t kstep = (size_t)(BK * 2);
    const size_t hstep = (size_t)HALF * K * 2;
    const size_t tstep = 2 * hstep;
    const unsigned ldsw = (unsigned)wid * 1024u;
    const int aoff = lds_byte(wr * 64 + fr, fq * 8), boff = lds_byte(wc * 32 + fr, fq * 8);
#define PG8_SA(b, h) (((b) * 2 + (h)) * HTB)
#define PG8_SB(b, h) ((4 + (b) * 2 + (h)) * HTB)
#define PG8_STAGE(bufoff, gbase, voff) do { _Pragma("unroll") for (int _i = 0; _i < 2; ++_i) \
        __builtin_amdgcn_global_load_lds((const unsigned*)((const char*)(gbase) + (voff)[_i]), (PG8_LAS unsigned*)(lds + (bufoff) + ldsw + _i * 8192), 16, 0, 0); } while (0)
#define PG8_LDA(dst, b, h) do { _Pragma("unroll") for (int m = 0; m < 4; ++m) _Pragma("unroll") for (int k = 0; k < 2; ++k) dst[m][k] = *(const PG8_LAS bf16x8*)(lds + PG8_SA(b, h) + aoff + m * 2048 + k * 1024); } while (0)
#define PG8_LDB(dst, b, h) do { _Pragma("unroll") for (int n = 0; n < 2; ++n) _Pragma("unroll") for (int k = 0; k < 2; ++k) dst[n][k] = *(const PG8_LAS bf16x8*)(lds + PG8_SB(b, h) + boff + n * 2048 + k * 1024); } while (0)
#define PG8_MMA(ai, bj, At, Bt) do { __builtin_amdgcn_s_setprio(1); _Pragma("unroll") for (int m = 0; m < 4; ++m) _Pragma("unroll") for (int n = 0; n < 2; ++n) _Pragma("unroll") for (int k = 0; k < 2; ++k) \
        acc[ai][bj][m][n] = __builtin_amdgcn_mfma_f32_16x16x32_bf16(Bt[n][k], At[m][k], acc[ai][bj][m][n], 0, 0, 0); __builtin_amdgcn_s_setprio(0); } while (0)
#define PG8_WAIT_V(n) asm volatile("s_waitcnt vmcnt(" #n ")" ::: "memory")
#define PG8_WAIT_L(n) asm volatile("s_waitcnt lgkmcnt(" #n ")" ::: "memory")
#define PG8_BAR __builtin_amdgcn_s_barrier()
#define PG8_SCHED __builtin_amdgcn_sched_barrier(0)
    Unit cur, nxt; int ui = 0;
    if (!S.next(0, cur)) return;
    f32x4 acc[2][2][4][2];
#pragma unroll
    for (int a = 0; a < 2; ++a)
#pragma unroll
        for (int b = 0; b < 2; ++b)
#pragma unroll
            for (int m = 0; m < 4; ++m)
#pragma unroll
                for (int n = 0; n < 2; ++n) acc[a][b][m][n] = (f32x4){0.f, 0.f, 0.f, 0.f};
    bf16x8 At[4][2], B0[2][2], B1[2][2];
    const char* cA = (const char*)g.A + (size_t)cur.pm * tstep; const char* cB = (const char*)g.Bt + (size_t)cur.pn * tstep;
    S.a_ready(cur);
    if constexpr (SP2) {
        PG8_STAGE(PG8_SB(0, 0), cB, voffB); PG8_STAGE(PG8_SB(0, 1), cB + hstep, voffB); PG8_STAGE(PG8_SA(0, 0), cA, voffA); PG8_STAGE(PG8_SA(0, 1), cA + hstep, voffA);
        if (wr == 1) PG8_BAR;
        PG8_WAIT_V(2); PG8_BAR;
        PG8_STAGE(PG8_SB(1, 0), cB + kstep, voffB); PG8_STAGE(PG8_SA(1, 0), cA + kstep, voffA); PG8_STAGE(PG8_SB(1, 1), cB + hstep + kstep, voffB);
        PG8_WAIT_V(6); PG8_BAR;
    } else {
        PG8_STAGE(PG8_SB(0, 0), cB, voffB); PG8_STAGE(PG8_SA(0, 0), cA, voffA); PG8_STAGE(PG8_SB(0, 1), cB + hstep, voffB); PG8_STAGE(PG8_SA(0, 1), cA + hstep, voffA);
        if (wr == 1) PG8_BAR;
        PG8_WAIT_V(4); PG8_BAR;
        PG8_STAGE(PG8_SB(1, 0), cB + kstep, voffB); PG8_STAGE(PG8_SA(1, 0), cA + kstep, voffA); PG8_STAGE(PG8_SB(1, 1), cB + hstep + kstep, voffB);
        PG8_WAIT_V(6); PG8_BAR;
    }
    for (;;) {
        const bool has_next = S.next(ui + 1, nxt);
        const char* nA = has_next ? (const char*)g.A + (size_t)nxt.pm * tstep : cA; const char* nB = has_next ? (const char*)g.Bt + (size_t)nxt.pn * tstep : cB;
        for (int t = 0; t < nt; t += 2) {
            const bool last = (t == nt - 2);
            const char* a1 = cA + (size_t)(t + 1) * kstep;
            const char* a2 = last ? nA : cA + (size_t)(t + 2) * kstep; const char* b2 = last ? nB : cB + (size_t)(t + 2) * kstep;
            const char* a3 = a2 + kstep; const char* b3 = b2 + kstep;
            if (last && has_next) S.a_ready(nxt);
            if constexpr (SP2) {
            PG8_LDB(B0, 0, 0); PG8_LDB(B1, 0, 1); PG8_SCHED; PG8_LDA(At, 0, 0); PG8_STAGE(PG8_SA(1, 1), a1 + hstep, voffA);
            PG8_WAIT_V(8); PG8_WAIT_L(0); PG8_BAR; PG8_MMA(0, 0, At, B0); PG8_MMA(0, 1, At, B1); PG8_BAR; PG8_SCHED;
            PG8_LDA(At, 0, 1); PG8_STAGE(PG8_SB(0, 0), b2, voffB); PG8_STAGE(PG8_SB(0, 1), b2 + hstep, voffB); PG8_STAGE(PG8_SA(0, 0), a2, voffA);
            PG8_WAIT_V(8); PG8_WAIT_L(0); PG8_BAR; PG8_MMA(1, 0, At, B0); PG8_MMA(1, 1, At, B1); PG8_BAR; PG8_SCHED;
            PG8_LDB(B0, 1, 0); PG8_LDB(B1, 1, 1); PG8_SCHED; PG8_LDA(At, 1, 0); PG8_STAGE(PG8_SA(0, 1), a2 + hstep, voffA);
            PG8_WAIT_V(8); PG8_WAIT_L(0); PG8_BAR; PG8_MMA(0, 0, At, B0); PG8_MMA(0, 1, At, B1); PG8_BAR; PG8_SCHED;
            PG8_LDA(At, 1, 1); PG8_STAGE(PG8_SB(1, 0), b3, voffB); PG8_STAGE(PG8_SB(1, 1), b3 + hstep, voffB); PG8_STAGE(PG8_SA(1, 0), a3, voffA);
            PG8_WAIT_V(8); PG8_WAIT_L(0); PG8_BAR; PG8_MMA(1, 0, At, B0); PG8_MMA(1, 1, At, B1); PG8_BAR; PG8_SCHED;
            } else {
            PG8_LDB(B0, 0, 0); PG8_SCHED; PG8_LDA(At, 0, 0); PG8_STAGE(PG8_SA(1, 1), a1 + hstep, voffA);
            PG8_WAIT_L(8); PG8_BAR; PG8_WAIT_L(0); PG8_MMA(0, 0, At, B0); PG8_BAR; PG8_SCHED;
            PG8_LDB(B1, 0, 1); PG8_STAGE(PG8_SB(0, 0), b2, voffB);
            PG8_BAR; PG8_WAIT_L(0); PG8_MMA(0, 1, At, B1); PG8_BAR;
            PG8_LDA(At, 0, 1); PG8_STAGE(PG8_SA(0, 0), a2, voffA);
            PG8_BAR; PG8_WAIT_L(0); PG8_MMA(1, 0, At, B0); PG8_BAR; PG8_SCHED;
            PG8_STAGE(PG8_SB(0, 1), b2 + hstep, voffB);
            PG8_WAIT_V(6); PG8_BAR; PG8_MMA(1, 1, At, B1); PG8_BAR;
            PG8_LDB(B0, 1, 0); PG8_SCHED; PG8_LDA(At, 1, 0); PG8_STAGE(PG8_SA(0, 1), a2 + hstep, voffA);
            PG8_WAIT_L(8); PG8_BAR; PG8_WAIT_L(0); PG8_MMA(0, 0, At, B0); PG8_BAR; PG8_SCHED;
            PG8_LDB(B1, 1, 1); PG8_STAGE(PG8_SB(1, 0), b3, voffB);
            PG8_BAR; PG8_WAIT_L(0); PG8_MMA(0, 1, At, B1); PG8_BAR;
            PG8_LDA(At, 1, 1); PG8_STAGE(PG8_SA(1, 0), a3, voffA);
            PG8_BAR; PG8_WAIT_L(0); PG8_MMA(1, 0, At, B0); PG8_BAR; PG8_SCHED;
            PG8_STAGE(PG8_SB(1, 1), b3 + hstep, voffB);
            PG8_WAIT_V(6); PG8_BAR; PG8_MMA(1, 1, At, B1); PG8_BAR;
            }
        }
        if constexpr (ALIGN_EPI) { if (wr == 0) PG8_BAR; }
        if constexpr (!Epi::AFTER_DRAIN) { E(acc, cur, wr, wc, fr, fq); S.done(cur); }
        if (!has_next) break;
#pragma unroll
        for (int a = 0; a < 2; ++a)
#pragma unroll
            for (int b = 0; b < 2; ++b)
#pragma unroll
                for (int m = 0; m < 4; ++m)
#pragma unroll
                    for (int n = 0; n < 2; ++n) acc[a][b][m][n] = (f32x4){0.f, 0.f, 0.f, 0.f};
        cur = nxt; cA = nA; cB = nB; ++ui;
        if constexpr (ALIGN_EPI) { if (wr == 1) PG8_BAR; }
    }
    PG8_WAIT_V(0);
    if constexpr (!ALIGN_EPI) { if (wr == 0) PG8_BAR; }
    PG8_BAR;
    if constexpr (Epi::AFTER_DRAIN) { E.fused(acc, cur, wr, wc, fr, fq, lds, wid, lane); S.done(cur); }
#undef PG8_SA
#undef PG8_SB
#undef PG8_STAGE
#undef PG8_LDA
#undef PG8_LDB
#undef PG8_MMA
#undef PG8_WAIT_V
#undef PG8_WAIT_L
#undef PG8_BAR
#undef PG8_SCHED
}
}
namespace att {
#define LAS __attribute__((address_space(3)))
typedef unsigned short bf16_t;
typedef short bf16x8 __attribute__((ext_vector_type(8)));
typedef float f32x16 __attribute__((ext_vector_type(16)));
typedef float f32x4 __attribute__((ext_vector_type(4)));
typedef unsigned u32x4 __attribute__((ext_vector_type(4)));
typedef unsigned u32x2 __attribute__((ext_vector_type(2)));
constexpr float LOG2E = 1.4426950408889634f;
constexpr float NEG = -1.0e30f;
constexpr int LDQK = 5120;
__device__ __forceinline__ f32x16 mfma(bf16x8 a, bf16x8 b, f32x16 c) { return __builtin_amdgcn_mfma_f32_32x32x16_bf16(a, b, c, 0, 0, 0); }
#define GAS __attribute__((address_space(1)))
__device__ __forceinline__ bf16x8 ld16(const bf16_t* p) { return *(const GAS bf16x8*)p; }
__device__ __forceinline__ unsigned cvtpk(float lo, float hi) { typedef float f2 __attribute__((ext_vector_type(2))); typedef __bf16 b2 __attribute__((ext_vector_type(2))); f2 v = {lo, hi}; b2 b = __builtin_convertvector(v, b2); return __builtin_bit_cast(unsigned, b); }
__device__ __forceinline__ bf16x8 pack8(float a0, float a1, float a2, float a3, float a4, float a5, float a6, float a7) {
    u32x4 w; w.x = cvtpk(a0, a1); w.y = cvtpk(a2, a3); w.z = cvtpk(a4, a5); w.w = cvtpk(a6, a7); return __builtin_bit_cast(bf16x8, w); }
__device__ __forceinline__ float ex2(float x) { return __builtin_amdgcn_exp2f(x); }
__device__ __forceinline__ float lg2(float x) { return __builtin_amdgcn_logf(x); }
__device__ __forceinline__ int kperm(int m) { return ((m >> 4) << 4) | (((m >> 2) & 1) << 3) | (((m >> 3) & 1) << 2) | (m & 3); }
__device__ __forceinline__ int rel_bucket(int d) { if (d < 16) return d; const float lr = logf((float)d / 16.0f) / 4.852030263919617f; const int large = 16 + (int)(lr * 16.0f); return large < 31 ? large : 31; }
__device__ __forceinline__ float xchg32(float x, int hi) { const auto rr = __builtin_amdgcn_permlane32_swap(__float_as_uint(x), __float_as_uint(x), false, false); return __uint_as_float(hi ? rr[0] : rr[1]); }
#define KL(r, hi) (16 * ((r) >> 3) + 8 * (hi) + ((r) & 7))

#ifndef FAST1
#define FAST1 1
#endif
#ifndef FAST2
#define FAST2 1
#endif
#define A_P1_TILE(JT, KBP) do { if (2 * (JT) + hfw <= sb) { { const LAS unsigned char* kr = (KBP) + ka_off; const int dbase = qpos - (2 * (JT) + hfw) * 32 - 8 * hi; const LAS float* tp = tbl + (dbase + 32 - 23); f32x16 S[2]; _Pragma("unroll") for (int mp = 0; mp < 2; ++mp) { f32x16 s = {0.f, 0.f, 0.f, 0.f, 0.f, 0.f, 0.f, 0.f, 0.f, 0.f, 0.f, 0.f, 0.f, 0.f, 0.f, 0.f}; _Pragma("unroll") for (int st = 0; st < 4; ++st) s = mfma(*(const LAS bf16x8*)(kr + mp * 128 + st * 32), qf[mp][st], s); S[mp] = s; } float mt0 = NEG, mt1 = NEG; _Pragma("unroll") for (int r = 0; r < 16; ++r) { const int c = (r & 7) + 16 * (r >> 3); const float bb = tp[23 - c]; const bool ok = c <= dbase; const float v0 = ok ? S[0][r] * SC + bb : NEG, v1 = ok ? S[1][r] * SC + bb : NEG; S[0][r] = v0; S[1][r] = v1; mt0 = fmaxf(mt0, v0); mt1 = fmaxf(mt1, v1); } const float mn0 = fmaxf(mx[0], mt0), mn1 = fmaxf(mx[1], mt1); float a0 = 0.f, a1 = 0.f; _Pragma("unroll") for (int r = 0; r < 16; ++r) { a0 += ex2(S[0][r] - mn0); a1 += ex2(S[1][r] - mn1); } sm[0] = sm[0] * ex2(mx[0] - mn0) + a0; mx[0] = mn0; sm[1] = sm[1] * ex2(mx[1] - mn1) + a1; mx[1] = mn1; } } } while (0)
#define A_P2_TILE(JT, KBP, VBP) do { if (2 * (JT) + hfw <= sb) { { const LAS unsigned char* kr = (KBP) + ka_off; const int dbase = qpos - (2 * (JT) + hfw) * 32 - 8 * hi; const LAS float* tp = tbl + (dbase + 32 - 23); f32x16 s0v = {0.f, 0.f, 0.f, 0.f, 0.f, 0.f, 0.f, 0.f, 0.f, 0.f, 0.f, 0.f, 0.f, 0.f, 0.f, 0.f}, s1v = s0v; _Pragma("unroll") for (int st = 0; st < 4; ++st) { s0v = mfma(*(const LAS bf16x8*)(kr + st * 32), qf[0][st], s0v); s1v = mfma(*(const LAS bf16x8*)(kr + 128 + st * 32), qf[1][st], s1v); } float w[16]; _Pragma("unroll") for (int r = 0; r < 16; ++r) { const int c = (r & 7) + 16 * (r >> 3); const float bb = tp[23 - c]; const float e0 = ex2(s0v[r] * SC + (bb - Mf[0])), e1 = ex2(s1v[r] * SC + (bb - Mf[1])); w[r] = c <= dbase ? (e0 * c0 - e1 * c1) : 0.f; } const bf16x8 pb0 = pack8(w[0], w[1], w[2], w[3], w[4], w[5], w[6], w[7]), pb1 = pack8(w[8], w[9], w[10], w[11], w[12], w[13], w[14], w[15]); const LAS unsigned char* vr = (VBP) + va_off; _Pragma("unroll") for (int k = 0; k < 4; ++k) { O[k] = mfma(*(const LAS bf16x8*)(vr + k * 32 * VROW), pb0, O[k]); O[k] = mfma(*(const LAS bf16x8*)(vr + k * 32 * VROW + 32), pb1, O[k]); } } } } while (0)
constexpr int KROW = 272, VROW = 144, KBUF = 64 * KROW, VBUF = 128 * VROW;
__device__ __forceinline__ void attnA_unit(LAS unsigned char* lds, const bf16_t* QK, const bf16_t* VT, bf16_t* ODA, int Mc, int b, int h, int blk,
                                           const float* lam4, const float* normg, const float* relb, float lam_init, int tid, int wave, int lane) {
    LAS float* tbl = (LAS float*)lds;
    LAS unsigned char* Kb = lds + 16640; LAS unsigned char* Vb = lds + 16640 + 2 * KBUF;
    asm volatile("" : "+v"(tid), "+v"(lane));
    LAS float* red = (LAS float*)(lds + 129024);
    __syncthreads();
    for (int d = tid; d < 4096 + 32; d += 512) tbl[d] = d < 32 ? 0.f : relb[rel_bucket(d - 32) * 16 + h] * LOG2E;
    if (tid < 128) red[tid] = lam4[(tid & 63) + 2 * (tid & 64)] * lam4[64 + (tid & 63) + 2 * (tid & 64)];
    const int hi = lane >> 5, ql = lane & 31;
    const int sb = 4 * blk + (wave & 3), hfw = wave >> 2;
    const int qpos = sb * 32 + ql;
    const size_t tokbase = (size_t)b * 4096;
    const float SC = 0.125f * LOG2E;
    const int NT = 2 * blk + 2;
    const bf16_t* qrow = QK + (tokbase + qpos) * LDQK + h * 128 + hi * 8;
    bf16x8 qf[2][4];
#pragma unroll
    for (int mp = 0; mp < 2; ++mp)
#pragma unroll
        for (int st = 0; st < 4; ++st) qf[mp][st] = ld16(qrow + mp * 64 + st * 16);
    const bf16_t* kg = QK + (tokbase + (tid >> 4)) * LDQK + 512 + h * 128 + (tid & 15) * 8;
    const int kl_off = (tid >> 4) * KROW + (tid & 15) * 16;
    const bf16_t* vg = VT + (size_t)(h * 128 + (tid >> 3)) * Mc + tokbase + (tid & 7) * 8;
    const int vl_off = (tid >> 3) * VROW + (tid & 7) * 16;
    const int ka_off = (hfw * 32 + kperm(ql)) * KROW + hi * 16, va_off = ql * VROW + hi * 16 + hfw * 64;
    bf16x8 kp0, kp1, vp0, vp1;
    kp0 = ld16(kg); kp1 = ld16(kg + (size_t)32 * LDQK);
    *(LAS bf16x8*)(Kb + kl_off) = kp0; *(LAS bf16x8*)(Kb + kl_off + 32 * KROW) = kp1;
    __syncthreads();
    float mx[2] = {NEG, NEG}, sm[2] = {0.f, 0.f};
    bf16x8 kq0, kq1;
    { const bf16_t* g2 = kg + (size_t)64 * LDQK; kp0 = ld16(g2); kp1 = ld16(g2 + (size_t)32 * LDQK); }
    for (int jt = 0; jt < NT; jt += 2) {
        if (jt + 2 < NT) { const bf16_t* g2 = kg + (size_t)(64 * (jt + 2)) * LDQK; kq0 = ld16(g2); kq1 = ld16(g2 + (size_t)32 * LDQK); }
        A_P1_TILE(jt, Kb);
        *(LAS bf16x8*)(Kb + KBUF + kl_off) = kp0; *(LAS bf16x8*)(Kb + KBUF + kl_off + 32 * KROW) = kp1;
        __syncthreads();
        if (jt + 3 < NT) { const bf16_t* g2 = kg + (size_t)(64 * (jt + 3)) * LDQK; kp0 = ld16(g2); kp1 = ld16(g2 + (size_t)32 * LDQK); }
        A_P1_TILE(jt + 1, Kb + KBUF);
        if (jt + 2 < NT) { *(LAS bf16x8*)(Kb + kl_off) = kq0; *(LAS bf16x8*)(Kb + kl_off + 32 * KROW) = kq1; }
        __syncthreads();
    }
    float Mf[2], iL[2];
    { LAS f32x4* ex = (LAS f32x4*)(lds + 90112);
      ex[wave * 64 + lane] = (f32x4){mx[0], sm[0], mx[1], sm[1]};
      __syncthreads();
      const f32x4 pa = ex[wave * 64 + (lane ^ 32)], pb = ex[(wave ^ 4) * 64 + lane], pc = ex[(wave ^ 4) * 64 + (lane ^ 32)];
#pragma unroll
      for (int mp = 0; mp < 2; ++mp) { const float M = fmaxf(fmaxf(mx[mp], pa[2 * mp]), fmaxf(pb[2 * mp], pc[2 * mp]));
          const float L = (sm[mp] * ex2(mx[mp] - M) + pa[2 * mp + 1] * ex2(pa[2 * mp] - M)) + (pb[2 * mp + 1] * ex2(pb[2 * mp] - M) + pc[2 * mp + 1] * ex2(pc[2 * mp] - M));
          Mf[mp] = M; iL[mp] = 1.0f / L; } }
    float s0 = 0.f, s1 = 0.f;
#pragma unroll 8
    for (int i = 0; i < 64; ++i) { s0 += red[i]; s1 += red[64 + i]; }
    const float lam = expf(s0) - expf(s1) + lam_init;
    const float c0 = iL[0], c1 = lam * iL[1];
    f32x16 O[4];
#pragma unroll
    for (int k = 0; k < 4; ++k) O[k] = (f32x16){0.f, 0.f, 0.f, 0.f, 0.f, 0.f, 0.f, 0.f, 0.f, 0.f, 0.f, 0.f, 0.f, 0.f, 0.f, 0.f};
    kp0 = ld16(kg); kp1 = ld16(kg + (size_t)32 * LDQK); vp0 = ld16(vg); vp1 = ld16(vg + (size_t)64 * Mc);
    *(LAS bf16x8*)(Kb + kl_off) = kp0; *(LAS bf16x8*)(Kb + kl_off + 32 * KROW) = kp1;
    *(LAS bf16x8*)(Vb + vl_off) = vp0; *(LAS bf16x8*)(Vb + vl_off + 64 * VROW) = vp1;
    __syncthreads();
    bf16x8 vq0, vq1;
    { const bf16_t* g2 = kg + (size_t)64 * LDQK; kp0 = ld16(g2); kp1 = ld16(g2 + (size_t)32 * LDQK); const bf16_t* g3 = vg + 64; vp0 = ld16(g3); vp1 = ld16(g3 + (size_t)64 * Mc); }
    for (int jt = 0; jt < NT; jt += 2) {
        if (jt + 2 < NT) { const bf16_t* g2 = kg + (size_t)(64 * (jt + 2)) * LDQK; kq0 = ld16(g2); kq1 = ld16(g2 + (size_t)32 * LDQK);
                           const bf16_t* g3 = vg + 64 * (jt + 2); vq0 = ld16(g3); vq1 = ld16(g3 + (size_t)64 * Mc); }
        A_P2_TILE(jt, Kb, Vb);
        *(LAS bf16x8*)(Kb + KBUF + kl_off) = kp0; *(LAS bf16x8*)(Kb + KBUF + kl_off + 32 * KROW) = kp1; *(LAS bf16x8*)(Vb + VBUF + vl_off) = vp0; *(LAS bf16x8*)(Vb + VBUF + vl_off + 64 * VROW) = vp1;
        __syncthreads();
        if (jt + 3 < NT) { const bf16_t* g2 = kg + (size_t)(64 * (jt + 3)) * LDQK; kp0 = ld16(g2); kp1 = ld16(g2 + (size_t)32 * LDQK);
                           const bf16_t* g3 = vg + 64 * (jt + 3); vp0 = ld16(g3); vp1 = ld16(g3 + (size_t)64 * Mc); }
        A_P2_TILE(jt + 1, Kb + KBUF, Vb + VBUF);
        if (jt + 2 < NT) { *(LAS bf16x8*)(Kb + kl_off) = kq0; *(LAS bf16x8*)(Kb + kl_off + 32 * KROW) = kq1; *(LAS bf16x8*)(Vb + vl_off) = vq0; *(LAS bf16x8*)(Vb + vl_off + 64 * VROW) = vq1; }
        __syncthreads();
    }
    LAS f32x4* oex = (LAS f32x4*)(lds + 16640);
    if (wave >= 4) {
#pragma unroll
        for (int k = 0; k < 4; ++k)
#pragma unroll
            for (int rr = 0; rr < 4; ++rr) oex[((wave - 4) * 16 + k * 4 + rr) * 64 + lane] = (f32x4){O[k][4 * rr], O[k][4 * rr + 1], O[k][4 * rr + 2], O[k][4 * rr + 3]};
    }
    __syncthreads();
    if (wave < 4) {
#pragma unroll
        for (int k = 0; k < 4; ++k)
#pragma unroll
            for (int rr = 0; rr < 4; ++rr) { const f32x4 t = oex[(wave * 16 + k * 4 + rr) * 64 + lane];
                O[k][4 * rr] += t[0]; O[k][4 * rr + 1] += t[1]; O[k][4 * rr + 2] += t[2]; O[k][4 * rr + 3] += t[3]; }
        float ss = 0.f;
#pragma unroll
        for (int k = 0; k < 4; ++k)
#pragma unroll
            for (int r = 0; r < 16; ++r) ss += O[k][r] * O[k][r];
        ss += xchg32(ss, hi);
        const float rs = (1.0f / sqrtf(ss * (1.0f / 128.0f) + 1e-5f)) * (1.0f - lam_init);
        bf16_t* orow = ODA + (tokbase + qpos) * 512 + h * 128 + 4 * hi;
#pragma unroll
        for (int k = 0; k < 4; ++k)
#pragma unroll
            for (int rr = 0; rr < 4; ++rr) { const int dv = 32 * k + 8 * rr; const f32x4 g = *(const GAS f32x4*)(normg + dv + 4 * hi);
                u32x2 o; o.x = cvtpk(O[k][4 * rr] * rs * g[0], O[k][4 * rr + 1] * rs * g[1]); o.y = cvtpk(O[k][4 * rr + 2] * rs * g[2], O[k][4 * rr + 3] * rs * g[3]);
                *(GAS u32x2*)(orow + dv) = o; }
    }
}

__device__ __forceinline__ void attnB_unit(const bf16_t* QK, const bf16_t* VT, bf16_t* OSB, int Mc, int b, int h, int qb, int wave, int lane) {
    asm volatile("" : "+v"(lane));
    const int hi = lane >> 5, ql = lane & 31;
    const int sb = qb * 8 + wave; const int qpos = sb * 32 + ql;
    const size_t tokbase = (size_t)b * 4096;
    const float SC = 0.125f * LOG2E;
    const bf16_t* qrow = QK + (tokbase + qpos) * LDQK + 1024 + h * 64 + hi * 8;
    bf16x8 qf[4];
#pragma unroll
    for (int st = 0; st < 4; ++st) qf[st] = ld16(qrow + st * 16);
    const bf16_t* kbase = QK + (tokbase + kperm(ql)) * LDQK + 1536 + h * 64 + hi * 8;
    const bf16_t* vbase = VT + (size_t)(512 + h * 64 + ql) * Mc + tokbase + 8 * hi;
    f32x16 O[2];
#pragma unroll
    for (int k = 0; k < 2; ++k) O[k] = (f32x16){0.f, 0.f, 0.f, 0.f, 0.f, 0.f, 0.f, 0.f, 0.f, 0.f, 0.f, 0.f, 0.f, 0.f, 0.f, 0.f};
    float carry = 0.f;
    bf16x8 kf[4];
    { const bf16_t* kr = kbase + (size_t)(sb * 32) * LDQK;
#pragma unroll
      for (int st = 0; st < 4; ++st) kf[st] = ld16(kr + st * 16); }
    for (int j = sb; j >= 0; --j) {
        bf16x8 vf[4];
        { const bf16_t* vr = vbase + j * 32;
#pragma unroll
          for (int k = 0; k < 2; ++k) { vf[2 * k] = ld16(vr + (size_t)(k * 32) * Mc); vf[2 * k + 1] = ld16(vr + (size_t)(k * 32) * Mc + 16); } }
        f32x16 s = {0.f, 0.f, 0.f, 0.f, 0.f, 0.f, 0.f, 0.f, 0.f, 0.f, 0.f, 0.f, 0.f, 0.f, 0.f, 0.f};
#pragma unroll
        for (int st = 0; st < 4; ++st) s = mfma(kf[st], qf[st], s);
        if (j > 0) { const bf16_t* kr = kbase + (size_t)((j - 1) * 32) * LDQK;
#pragma unroll
            for (int st = 0; st < 4; ++st) kf[st] = ld16(kr + st * 16); }
        const int dbase = qpos - j * 32 - 8 * hi;
        float lk[16], zz[16];
#pragma unroll
        for (int r = 0; r < 16; ++r) { const int d = dbase - (r & 7) - 16 * (r >> 3); const float z2 = s[r] * SC;
            const float sp = fmaxf(z2, 0.f) + lg2(1.0f + ex2(-fabsf(z2)));
            lk[r] = d > 0 ? -sp : 0.f; zz[r] = d > 0 ? z2 : NEG; }
        float sf[16]; float T0 = 0.f, T1 = 0.f;
#pragma unroll
        for (int r = 7; r >= 0; --r) { sf[r] = T0; T0 += lk[r]; }
#pragma unroll
        for (int r = 15; r >= 8; --r) { sf[r] = T1; T1 += lk[r]; }
        const float P0 = xchg32(T0, hi), P1 = xchg32(T1, hi);
        const float add0 = carry + (hi == 0 ? (P0 + T1 + P1) : (P1 + T1));
        const float add1 = carry + (hi == 0 ? P1 : 0.f);
        float a[16];
#pragma unroll
        for (int r = 0; r < 16; ++r) a[r] = ex2(zz[r] + lk[r] + sf[r] + (r < 8 ? add0 : add1));
        const bf16x8 pb0 = pack8(a[0], a[1], a[2], a[3], a[4], a[5], a[6], a[7]), pb1 = pack8(a[8], a[9], a[10], a[11], a[12], a[13], a[14], a[15]);
#pragma unroll
        for (int k = 0; k < 2; ++k) { O[k] = mfma(vf[2 * k], pb0, O[k]); O[k] = mfma(vf[2 * k + 1], pb1, O[k]); }
        carry += (T0 + T1) + (P0 + P1);
        if (__all(carry < -160.0f)) break;
    }
    bf16_t* orow = OSB + (tokbase + qpos) * 512 + h * 64 + 4 * hi;
#pragma unroll
    for (int k = 0; k < 2; ++k)
#pragma unroll
        for (int rr = 0; rr < 4; ++rr) { u32x2 o; o.x = cvtpk(O[k][4 * rr], O[k][4 * rr + 1]); o.y = cvtpk(O[k][4 * rr + 2], O[k][4 * rr + 3]); *(GAS u32x2*)(orow + 32 * k + 8 * rr) = o; }
}

__device__ __forceinline__ void attnC_unit(LAS float* tblC, const bf16_t* QK, const bf16_t* VT, float* SCR, float* LSE, bf16_t* ODL, int Mc, int b, int hh, int R,
                                           const float* relb, int tid, int wave, int lane) {
    asm volatile("" : "+v"(tid), "+v"(lane));
    __syncthreads();
    for (int i = tid; i < 3 * 129; i += 512) { const int g = i / 129, j = i - g * 129; tblC[g * 132 + j] = relb[rel_bucket(j << (2 * g)) * 16 + 4 + g * 4 + hh] * LOG2E; }
    __syncthreads();
    const int hi = lane >> 5, ql = lane & 31;
    const size_t tokbase = (size_t)b * 4096;
    const float SC = 0.08838834764831845f * LOG2E;
#pragma unroll 1
    for (int g = 0; g < 3; ++g) {
        const int ld = 2 * g, nmb = 16 >> ld;
#pragma unroll 1
        for (int tt = 0; tt < 2; ++tt) {
            const int t = wave * 2 + tt; const int res = t / nmb, mb = t - res * nmb;
            const int m0 = R * (512 >> ld) + 32 * mb;
            const int token = ((m0 + ql) << ld) + res;
            const bf16_t* qrow = QK + (tokbase + token) * LDQK + 2048 + g * 512 + hh * 128 + hi * 8;
            bf16x8 qf[8];
#pragma unroll
            for (int st = 0; st < 8; ++st) qf[st] = ld16(qrow + st * 16);
            f32x16 O[4];
#pragma unroll
            for (int k = 0; k < 4; ++k) O[k] = (f32x16){0.f, 0.f, 0.f, 0.f, 0.f, 0.f, 0.f, 0.f, 0.f, 0.f, 0.f, 0.f, 0.f, 0.f, 0.f, 0.f};
            const bf16_t* kbase = QK + (tokbase + res) * LDQK + 3584 + g * 512 + hh * 128 + hi * 8;
            const bf16_t* vbase = VT + (size_t)(1024 + g * 512 + hh * 128 + ql) * Mc + tokbase + res * (4096 >> ld) + 8 * hi;
            const LAS float* tg = tblC + g * 132;
            float M = NEG, Ll = 0.f;
            const int jt0 = m0 >= 128 ? 0 : ((128 - m0) >> 5);
            bf16x8 kf[8];
            { const bf16_t* kr = kbase + ((size_t)(m0 - 128 + 32 * jt0 + kperm(ql)) << ld) * LDQK;
#pragma unroll
              for (int st = 0; st < 8; ++st) kf[st] = ld16(kr + st * 16); }
#pragma unroll 1
            for (int jt = jt0; jt < 5; ++jt) {
                const int mt0 = m0 - 128 + 32 * jt;
                bf16x8 vf[8];
                { const bf16_t* vr = vbase + mt0;
#pragma unroll
                  for (int k = 0; k < 4; ++k) { vf[2 * k] = ld16(vr + (size_t)(k * 32) * Mc); vf[2 * k + 1] = ld16(vr + (size_t)(k * 32) * Mc + 16); } }
                f32x16 s = {0.f, 0.f, 0.f, 0.f, 0.f, 0.f, 0.f, 0.f, 0.f, 0.f, 0.f, 0.f, 0.f, 0.f, 0.f, 0.f};
#pragma unroll
                for (int st = 0; st < 8; ++st) s = mfma(kf[st], qf[st], s);
                if (jt + 1 < 5) { const bf16_t* kr = kbase + ((size_t)(mt0 + 32 + kperm(ql)) << ld) * LDQK;
#pragma unroll
                    for (int st = 0; st < 8; ++st) kf[st] = ld16(kr + st * 16); }
                const int jb = 128 - 32 * jt + ql - 8 * hi;
                float mt = NEG;
#pragma unroll
                for (int r = 0; r < 16; ++r) { const int jd = jb - ((r & 7) + 16 * (r >> 3));
                    const bool ok = (jd >= 0) && (jd <= 128);
                    const float v = ok ? s[r] * SC + tg[jd < 0 ? 0 : (jd > 128 ? 128 : jd)] : NEG; s[r] = v; mt = fmaxf(mt, v); }
                mt = fmaxf(mt, xchg32(mt, hi));
                const float mn = fmaxf(M, mt), al = ex2(M - mn); M = mn;
                float a = 0.f;
#pragma unroll
                for (int r = 0; r < 16; ++r) { const float e = ex2(s[r] - mn); s[r] = e; a += e; }
                Ll = Ll * al + a;
#pragma unroll
                for (int k = 0; k < 4; ++k)
#pragma unroll
                    for (int r = 0; r < 16; ++r) O[k][r] *= al;
                const bf16x8 pb0 = pack8(s[0], s[1], s[2], s[3], s[4], s[5], s[6], s[7]), pb1 = pack8(s[8], s[9], s[10], s[11], s[12], s[13], s[14], s[15]);
#pragma unroll
                for (int k = 0; k < 4; ++k) { O[k] = mfma(vf[2 * k], pb0, O[k]); O[k] = mfma(vf[2 * k + 1], pb1, O[k]); }
            }
            const float L = Ll + xchg32(Ll, hi);
            { const float iL = 1.0f / L;
#pragma unroll
              for (int k = 0; k < 4; ++k)
#pragma unroll
                for (int r = 0; r < 16; ++r) O[k][r] *= iL; }
            float lse = M + lg2(L);
            float* srow = SCR + (tokbase + token) * 512 + hh * 128 + 4 * hi;
            float* lp = LSE + (tokbase + token) * 4 + hh;
            if (g > 0) {
                const float lo = *(const GAS float*)lp; const float mxl = fmaxf(lo, lse);
                const float ea = ex2(lo - mxl), eb = ex2(lse - mxl); const float inv = 1.0f / (ea + eb);
                const float wa = ea * inv, wb = eb * inv; lse = mxl + lg2(ea + eb);
#pragma unroll
                for (int k = 0; k < 4; ++k)
#pragma unroll
                    for (int rr = 0; rr < 4; ++rr) { const f32x4 old = *(const GAS f32x4*)(srow + 32 * k + 8 * rr);
#pragma unroll
                        for (int e = 0; e < 4; ++e) O[k][4 * rr + e] = wa * old[e] + wb * O[k][4 * rr + e]; }
            }
            if (g < 2) {
#pragma unroll
                for (int k = 0; k < 4; ++k)
#pragma unroll
                    for (int rr = 0; rr < 4; ++rr) *(GAS f32x4*)(srow + 32 * k + 8 * rr) = (f32x4){O[k][4 * rr], O[k][4 * rr + 1], O[k][4 * rr + 2], O[k][4 * rr + 3]};
                if (hi == 0) *(GAS float*)lp = lse;
            } else {
                bf16_t* orow = ODL + (tokbase + token) * 512 + hh * 128 + 4 * hi;
#pragma unroll
                for (int k = 0; k < 4; ++k)
#pragma unroll
                    for (int rr = 0; rr < 4; ++rr) { u32x2 o; o.x = cvtpk(O[k][4 * rr], O[k][4 * rr + 1]); o.y = cvtpk(O[k][4 * rr + 2], O[k][4 * rr + 3]); *(GAS u32x2*)(orow + 32 * k + 8 * rr) = o; }
            }
        }
        if (g < 2) __syncthreads();
    }
}
}
constexpr int MTOK = 32768, DM = 1024, DFF = 4096, NPROJ = 10752, MC = 16384, NLAYER = 4;
constexpr size_t MiB = 1u << 20;
constexpr size_t WS_WIN = 1 * MiB, WS_WBR = 22 * MiB, WS_WOUT = 25 * MiB, WS_WUP = 27 * MiB, WS_WDOWN = 35 * MiB, WS_WG = 43 * MiB, WS_WP = 45 * MiB;
constexpr size_t WS_PB = 46 * MiB, WS_XB = 62 * MiB, WS_QK = 126 * MiB, WS_VT = 286 * MiB, WS_GT = 366 * MiB, WS_HID = 126 * MiB;
constexpr size_t WS_ODA = 462 * MiB, WS_OSB = 478 * MiB, WS_ODL = 494 * MiB, WS_SCR = 510 * MiB, WS_LSE = 542 * MiB, WS_MF = 543 * MiB, WS_MRG = 607 * MiB, WS_TMP = 462 * MiB, WS_END = 639 * MiB;
constexpr int LDS_BYTES = 143360;
constexpr float ALPHA = 1.681792830507429f;
typedef unsigned short bf16;
typedef unsigned v4u __attribute__((ext_vector_type(4)));
typedef float f32x4 __attribute__((ext_vector_type(4)));
__device__ __forceinline__ unsigned pk2(float lo, float hi) { return pg8::cvt_pk_bf16(lo, hi); }
__device__ __forceinline__ float wave_sum(float v, int lane) {
#pragma unroll
    for (int o = 1; o < 64; o <<= 1) v += __int_as_float(__builtin_amdgcn_ds_bpermute((lane ^ o) << 2, __float_as_int(v)));
    return v; }
__device__ __forceinline__ void transpose_item(const float* W, int K, int N, bf16* WT, LAS float* scr, int item, int lane) {
    const int nblk = N / 32, kb = item / nblk, nb = item - kb * nblk, k0 = 64 * kb, n0 = 32 * nb;
#pragma unroll 8
    for (int i = 0; i < 32; ++i) { const int kk = 2 * i + (lane >> 5); scr[kk * 33 + (lane & 31)] = ((const GAS float*)W)[(size_t)(k0 + kk) * N + n0 + (lane & 31)]; }
    asm volatile("s_waitcnt lgkmcnt(0)" ::: "memory");
    const int c = lane & 7;
#pragma unroll
    for (int j = 0; j < 4; ++j) { const int n = (lane >> 3) + 8 * j; const LAS float* s = scr + (8 * c) * 33 + n;
        v4u o; o.x = pk2(s[0 * 33], s[1 * 33]); o.y = pk2(s[2 * 33], s[3 * 33]); o.z = pk2(s[4 * 33], s[5 * 33]); o.w = pk2(s[6 * 33], s[7 * 33]);
        *(GAS v4u*)(WT + (size_t)(n0 + n) * K + k0 + 8 * c) = o; }
    asm volatile("s_waitcnt lgkmcnt(0)" ::: "memory");
}
#define XB_TMO      128
#define XB_XCNT(j)  (256  + 64 * (j))
#define XB_XSUB(j)  (1280 + 64 * (j))
#define XB_XGEN(j)  (2304 + 64 * (j))
#define XB_TOP      3328
#define XB_TOPGEN   3392
#define XCD_BAR_WORDS 3456
#define XB_SPIN_CAP (1u << 18)

__device__ __forceinline__ unsigned xb_ld(unsigned* p)              { return __hip_atomic_load(p, __ATOMIC_RELAXED, __HIP_MEMORY_SCOPE_AGENT); }
__device__ __forceinline__ unsigned xb_add(unsigned* p, unsigned v) { return __hip_atomic_fetch_add(p, v, __ATOMIC_RELAXED, __HIP_MEMORY_SCOPE_AGENT); }
__device__ __forceinline__ unsigned xb_xcc_id() { return (unsigned)__builtin_amdgcn_s_getreg((3 << 11) | 20) & 0xFu; }
#define XB_SPIN(cond, bar) do { unsigned _sp = 0; while (cond) { __builtin_amdgcn_s_sleep(1); \
    if ((++_sp & 255u) == 0u) { if (xb_ld(&(bar)[XB_TMO])) break; if (_sp > XB_SPIN_CAP) { atomicAdd(&(bar)[XB_TMO], 1u); break; } } } } while (0)

struct XcdBarrier {
    unsigned* bar; unsigned x;
    volatile LAS unsigned* st;
};

__device__ __forceinline__ XcdBarrier xcd_barrier_post(unsigned* bar, volatile LAS unsigned* st) {
    XcdBarrier b; b.bar = bar; b.x = xb_xcc_id(); b.st = st;
    if (threadIdx.x == 0) (void)xb_add(&bar[XB_XCNT(b.x)], 1u);
    return b;
}
__device__ __forceinline__ void xcd_barrier_complete(unsigned* bar, unsigned x, unsigned& nloc, unsigned& nx) {
    const unsigned G = gridDim.x * gridDim.y * gridDim.z;
    unsigned sum, cnt, mine, sp = 0u;
    for (;;) {
        sum = 0u; cnt = 0u; mine = 0u;
#pragma unroll
        for (unsigned j = 0; j < 16; ++j) { const unsigned c = xb_ld(&bar[XB_XCNT(j)]); sum += c; cnt += (c > 0u) ? 1u : 0u; mine = (j == x) ? c : mine; }
        if (sum == G) break;
        __builtin_amdgcn_s_sleep(1);
        if ((++sp & 255u) == 0u) { if (xb_ld(&bar[XB_TMO])) break; if (sp > XB_SPIN_CAP) { atomicAdd(&bar[XB_TMO], 1u); break; } }
    }
    nloc = mine > 0u ? mine : 1u; nx = cnt > 0u ? cnt : 1u;
}

__device__ __forceinline__ void xcd_barrier(const XcdBarrier& b) {
    asm volatile("s_waitcnt vmcnt(0)" ::: "memory");
    __syncthreads();
    if (threadIdx.x == 0) {
        unsigned* bar = b.bar;
        __builtin_amdgcn_s_waitcnt(0);
        unsigned nloc = b.st[0], nx = b.st[1];
        if (nloc == 0u) { xcd_barrier_complete(bar, b.x, nloc, nx); b.st[0] = nloc; b.st[1] = nx; }
        const unsigned old = xb_add(&bar[XB_XSUB(b.x)], 1u);
        const unsigned gen = old / nloc;
        if (old + 1u == (gen + 1u) * nloc) {
            __builtin_amdgcn_fence(__ATOMIC_RELEASE, "agent");
            asm volatile("s_waitcnt vmcnt(0)" ::: "memory");
            const unsigned og = xb_add(&bar[XB_TOP], 1u);
            const unsigned tg = og / nx;
            if (og + 1u == (tg + 1u) * nx) xb_add(&bar[XB_TOPGEN], 1u);
            else XB_SPIN(xb_ld(&bar[XB_TOPGEN]) == tg, bar);
            __builtin_amdgcn_fence(__ATOMIC_ACQUIRE, "agent");
            xb_add(&bar[XB_XGEN(b.x)], 1u);
            asm volatile("s_waitcnt vmcnt(0)" ::: "memory");
        } else {
            XB_SPIN(xb_ld(&bar[XB_XGEN(b.x)]) == gen, bar);
            __builtin_amdgcn_fence(__ATOMIC_ACQUIRE, "agent");
            asm volatile("s_waitcnt vmcnt(0)" ::: "memory");
        }
    }
    __syncthreads();
}

struct Args { const float* in[18]; float* out; unsigned char* ws; };
constexpr int PTAB_OFF = 131072 + 4096;
__device__ __forceinline__ const float* ldptr(LAS unsigned char* lds, int i) {
    const unsigned long long v = ((LAS unsigned long long*)(lds + PTAB_OFF))[i];
    const unsigned lo = __builtin_amdgcn_readfirstlane((unsigned)v), hi = __builtin_amdgcn_readfirstlane((unsigned)(v >> 32));
    return (const float*)(const GAS float*)(((unsigned long long)hi << 32) | lo); }
__device__ __forceinline__ void convert_layer(unsigned char* ws, int layer, LAS unsigned char* lds, int gw, int NGW, int wave, int lane) {
    LAS float* scr = (LAS float*)(lds + wave * 16384);
    constexpr int I_IN = 16 * 336, I_BR = 8 * 32, I_O = 16 * 32, I_UP = 16 * 128, I_DN = 64 * 32, I_G = 16 * 32, I_P = 4 * 32;
    constexpr int NIT = I_IN + 3 * I_BR + I_O + I_UP + I_DN + I_G + I_P;
    for (int it = gw; it < NIT; it += NGW) {
        int r = it;
        if (r < I_IN) { transpose_item(ldptr(lds, 2) + (size_t)layer * 1024 * NPROJ, 1024, NPROJ, (bf16*)(ws + WS_WIN), scr, r, lane); continue; } r -= I_IN;
        if (r < 3 * I_BR) { const int br = r / I_BR; transpose_item(ldptr(lds, 5 + br) + (size_t)layer * 512 * 1024, 512, 1024, (bf16*)(ws + WS_WBR) + (size_t)br * 1024 * 512, scr, r - br * I_BR, lane); continue; } r -= 3 * I_BR;
        if (r < I_O) { transpose_item(ldptr(lds, 8) + (size_t)layer * 1024 * 1024, 1024, 1024, (bf16*)(ws + WS_WOUT), scr, r, lane); continue; } r -= I_O;
        if (r < I_UP) { transpose_item(ldptr(lds, 11) + (size_t)layer * 1024 * 4096, 1024, 4096, (bf16*)(ws + WS_WUP), scr, r, lane); continue; } r -= I_UP;
        if (r < I_DN) { transpose_item(ldptr(lds, 12) + (size_t)layer * 4096 * 1024, 4096, 1024, (bf16*)(ws + WS_WDOWN), scr, r, lane); continue; } r -= I_DN;
        if (r < I_G) { transpose_item(ldptr(lds, 13) + (size_t)layer * 1024 * 1024, 1024, 1024, (bf16*)(ws + WS_WG), scr, r, lane); continue; } r -= I_G;
        transpose_item(ldptr(lds, 14) + (size_t)layer * 256 * 1024, 256, 1024, (bf16*)(ws + WS_WP), scr, r, lane);
    }
    const float* ps = ldptr(lds, 1) + (size_t)layer * MTOK * 256; bf16* pd = (bf16*)(ws + WS_PB);
    for (size_t i = (size_t)gw * 64 + lane; i < (size_t)MTOK * 256 / 8; i += (size_t)NGW * 64) {
        const f32x4 u = *(const GAS f32x4*)(ps + i * 8), v = *(const GAS f32x4*)(ps + i * 8 + 4);
        v4u o; o.x = pk2(u[0], u[1]); o.y = pk2(u[2], u[3]); o.z = pk2(v[0], v[1]); o.w = pk2(v[2], v[3]); *(GAS v4u*)(pd + i * 8) = o; }
}
__device__ __forceinline__ void ln_pass(float* Y, bf16* XB, const float* g, const float* bt, int gw, int NGW, int lane) {
    for (int m = gw; m < MTOK; m += 2 * NGW) {
        const int m2 = m + NGW;
        const bool two = m2 < MTOK;
        GAS f32x4* yr = (GAS f32x4*)(Y + (size_t)m * DM) + lane;
        GAS f32x4* yr2 = (GAS f32x4*)(Y + (size_t)(two ? m2 : m) * DM) + lane;
        f32x4 v[4], w[4]; float s = 0.f, t = 0.f;
#pragma unroll
        for (int j = 0; j < 4; ++j) { v[j] = yr[64 * j]; w[j] = yr2[64 * j]; }
#pragma unroll
        for (int j = 0; j < 4; ++j) { s += (v[j][0] + v[j][1]) + (v[j][2] + v[j][3]); t += (w[j][0] + w[j][1]) + (w[j][2] + w[j][3]); }
        const float mean = wave_sum(s, lane) * (1.f / DM), mean2 = wave_sum(t, lane) * (1.f / DM); float s2 = 0.f, t2 = 0.f;
#pragma unroll
        for (int j = 0; j < 4; ++j) { v[j] = v[j] - mean; s2 += (v[j][0] * v[j][0] + v[j][1] * v[j][1]) + (v[j][2] * v[j][2] + v[j][3] * v[j][3]);
                                      w[j] = w[j] - mean2; t2 += (w[j][0] * w[j][0] + w[j][1] * w[j][1]) + (w[j][2] * w[j][2] + w[j][3] * w[j][3]); }
        const float rstd = 1.f / sqrtf(wave_sum(s2, lane) * (1.f / DM) + 1e-5f), rstd2 = 1.f / sqrtf(wave_sum(t2, lane) * (1.f / DM) + 1e-5f);
        GAS unsigned long long* o8 = (GAS unsigned long long*)(XB + (size_t)m * DM) + lane;
        GAS unsigned long long* p8 = (GAS unsigned long long*)(XB + (size_t)(two ? m2 : m) * DM) + lane;
#pragma unroll
        for (int j = 0; j < 4; ++j) { const f32x4 gv = ((const GAS f32x4*)g)[lane + 64 * j], bv = ((const GAS f32x4*)bt)[lane + 64 * j];
            const f32x4 o = v[j] * rstd * gv + bv; yr[64 * j] = o;
            o8[64 * j] = (unsigned long long)pk2(o[0], o[1]) | ((unsigned long long)pk2(o[2], o[3]) << 32);
            if (two) { const f32x4 q = w[j] * rstd2 * gv + bv; yr2[64 * j] = q;
                p8[64 * j] = (unsigned long long)pk2(q[0], q[1]) | ((unsigned long long)pk2(q[2], q[3]) << 32); } }
    }
}

__global__ void __launch_bounds__(512, 2) mk_fwd(Args a) {
    extern __shared__ __attribute__((aligned(16))) unsigned char lds_raw[];
    LAS unsigned char* lds = (LAS unsigned char*)lds_raw;
    cg::grid_group grid = cg::this_grid();
    const int tid0 = threadIdx.x;
    const int G = gridDim.x, bid0 = blockIdx.x;
    const int NGW = G * 8;
    unsigned* const barw = (unsigned*)a.ws + 1024;
    if (bid0 == 0) for (int i = tid0; i < XCD_BAR_WORDS; i += 512) __hip_atomic_store(barw + i, 0u, __ATOMIC_RELAXED, __HIP_MEMORY_SCOPE_AGENT);
    volatile LAS unsigned* const bst = (volatile LAS unsigned*)(lds + PTAB_OFF + 256);
    if (tid0 < 2) bst[tid0] = 0u;
    if (tid0 == 0) { LAS unsigned long long* pt = (LAS unsigned long long*)(lds + PTAB_OFF);
#pragma unroll
        for (int i = 0; i < 18; ++i) pt[i] = (unsigned long long)a.in[i]; }
    __syncthreads();
    { const int lane = tid0 & 63, wave = __builtin_amdgcn_readfirstlane(tid0 >> 6), gw = bid0 * 8 + wave; unsigned char* ws = a.ws; bf16* XB = (bf16*)(ws + WS_XB);
      convert_layer(ws, 0, lds, gw, NGW, wave, lane);
      const float* xs = ldptr(lds, 0);
      for (size_t i = (size_t)gw * 64 + lane; i < (size_t)MTOK * DM / 8; i += (size_t)NGW * 64) {
          const f32x4 u = *(const GAS f32x4*)(xs + i * 8), v = *(const GAS f32x4*)(xs + i * 8 + 4);
          v4u o; o.x = pk2(u[0], u[1]); o.y = pk2(u[2], u[3]); o.z = pk2(v[0], v[1]); o.w = pk2(v[2], v[3]); *(GAS v4u*)(XB + i * 8) = o; } }
    grid.sync();
    const XcdBarrier xbar = xcd_barrier_post(barw, bst);
#if defined(PROBE_ATT2) || defined(PROBE_GEMM2)
    int rep = 0;
#endif
    for (int step = 0; step < NLAYER * 18; ++step) {
        const int layer = step / 18, s = step - layer * 18;
        int tid = tid0; asm volatile("" : "+v"(tid));
        const int lane = tid & 63, wave = __builtin_amdgcn_readfirstlane(tid >> 6);
        int bid = bid0; asm volatile("" : "+s"(bid));
        const int gw = bid * 8 + wave;
        unsigned char* ws_ = a.ws; asm volatile("" : "+s"(ws_));
        float* outp_ = a.out; asm volatile("" : "+s"(outp_));
        unsigned char* ws = (unsigned char*)(GAS unsigned char*)ws_;
        float* outp = (float*)(GAS float*)outp_;
        bf16* XB = (bf16*)(ws + WS_XB);
        int kind = 3; bool sync = true;
        pg8::Gemm g{nullptr, nullptr, 0, 0, 0};
        pg8::EpiB EB{0, (bf16*)(ws + WS_QK), (bf16*)(ws + WS_VT), (bf16*)(ws + WS_GT), (bf16*)(ws + WS_HID), MC};
        pg8::EpiF EF{0, nullptr, nullptr, outp, (const bf16*)(ws + WS_GT), (bf16*)(ws + WS_MRG), 0, 0, ALPHA};
        int chunk = 0;
        if (s < 12) {
            chunk = s / 6; const int k = s - chunk * 6;
            if (k == 0) { kind = 0; g = pg8::Gemm{XB + (size_t)chunk * MC * DM, (const bf16*)(ws + WS_WIN), MC, NPROJ, DM}; EB.mode = 0; }
            else if (k == 1) { kind = 2; }
            else if (k <= 4) { kind = 1; const int br = k - 2; sync = (k == 4);
                g = pg8::Gemm{(const bf16*)(ws + WS_ODA + (size_t)br * 16 * MiB), (const bf16*)(ws + WS_WBR) + (size_t)br * 1024 * 512, MC, DM, 512};
                EF.mode = br; EF.F = (float*)(ws + WS_MF); EF.gofs = br * 1024; }
            else { kind = 1; sync = (chunk == 1);
                g = pg8::Gemm{(const bf16*)(ws + WS_MRG), (const bf16*)(ws + WS_WOUT), MC, DM, DM};
                EF.mode = 3; EF.X = (layer == 0) ? ldptr(lds, 0) : outp; EF.rowoff = chunk * MC; }
        } else if (s == 12) { kind = 3; }
        else if (s == 13) { kind = 0; sync = false; g = pg8::Gemm{XB, (const bf16*)(ws + WS_WUP), MTOK, DFF, DM}; EB.mode = 1; }
        else if (s == 14) { kind = 1; sync = false; g = pg8::Gemm{XB, (const bf16*)(ws + WS_WG), MTOK, DM, DM}; EF.mode = 4; EF.F = (float*)(ws + WS_TMP); }
        else if (s == 15) { kind = 1; g = pg8::Gemm{(const bf16*)(ws + WS_PB), (const bf16*)(ws + WS_WP), MTOK, DM, 256}; EF.mode = 5; EF.F = (float*)(ws + WS_TMP); }
        else if (s == 16) { kind = 1; g = pg8::Gemm{(const bf16*)(ws + WS_HID), (const bf16*)(ws + WS_WDOWN), MTOK, DM, DFF}; EF.mode = 6; }
        else { kind = 4; }

#ifndef NO_GEMMB
        if (kind == 0) { pg8::StaticOrder S; S.init(g.M, g.N, G, bid); pg8::gemm_phase<pg8::EpiB, pg8::StaticOrder, true, true>(lds, g, S, EB, tid); }
#else
        if (0) {}
#endif
#ifndef NO_GEMMF
        else if (kind == 1) { pg8::StaticOrder S; S.init(g.M, g.N, G, bid); pg8::gemm_phase<pg8::EpiF, pg8::StaticOrder, true, true>(lds, g, S, EF, tid); }
#endif
#ifndef NO_ATT
        else if (kind == 2) {
            const bf16* QK = (const bf16*)(ws + WS_QK); const bf16* VT = (const bf16*)(ws + WS_VT);
            const float lam_init = 0.8f - 0.6f * expf(-0.3f * (float)layer);
#ifndef NO_A
#ifdef PROBE_A2
            for (int rep = 0; rep < 2; ++rep)
#endif
            for (int u = bid; u < 512; u += G) {
                const int v = u & 255, p = v & 15, blk = (u < 256) ? p : 31 - p;
                att::attnA_unit(lds, QK, VT, (bf16*)(ws + WS_ODA), MC, v >> 6, (v >> 4) & 3, blk, ldptr(lds, 3) + layer * 256, ldptr(lds, 4) + layer * 128, ldptr(lds, 17), lam_init, tid, wave, lane); }
#endif
#ifndef NO_C
            for (int u = bid; u < 128; u += G)
                att::attnC_unit((LAS float*)(lds + 126976), QK, VT, (float*)(ws + WS_SCR), (float*)(ws + WS_LSE), (bf16*)(ws + WS_ODL), MC, u >> 5, (u >> 3) & 3, u & 7, ldptr(lds, 17), tid, wave, lane);
#endif
#ifndef NO_B
            if (G > 128) { if (bid >= 128) for (int u = bid - 128; u < 512; u += G - 128) att::attnB_unit(QK, VT, (bf16*)(ws + WS_OSB), MC, u >> 7, (u >> 4) & 7, u & 15, wave, lane); }
            else for (int u = bid; u < 512; u += G) att::attnB_unit(QK, VT, (bf16*)(ws + WS_OSB), MC, u >> 7, (u >> 4) & 7, u & 15, wave, lane);
#endif
        }
#endif
        else if (kind == 3) { ln_pass(outp, XB, ldptr(lds, 9) + layer * DM, ldptr(lds, 10) + layer * DM, gw, NGW, lane); }
        else { ln_pass(outp, XB, ldptr(lds, 15) + layer * DM, ldptr(lds, 16) + layer * DM, gw, NGW, lane);
               if (layer + 1 < NLAYER) convert_layer(ws, layer + 1, lds, gw, NGW, wave, lane); }
#ifdef PROBE_ATT2
        if (kind == 2) { if (rep == 0) { rep = 1; --step; sync = false; } else rep = 0; }
#endif
#ifdef PROBE_GEMM2
        if (kind == 0) { if (rep == 0) { rep = 1; --step; sync = false; } else rep = 0; }
#endif
        if (sync && step + 1 < NLAYER * 18) { xcd_barrier(xbar);
#ifdef PROBE_SYNC2
            xcd_barrier(xbar);
#endif
        }
    }
}

extern "C" void kernel_launch(void* const* d_in, const int* in_sizes, int n_in, void* d_out, int out_size, void* d_ws, size_t ws_size, hipStream_t stream) {
    static int grid = 0;
    if (grid == 0) {
        if (n_in != 18 || out_size != MTOK * DM || ws_size < WS_END) { fprintf(stderr, "kernel_launch: unexpected shapes (n_in %d out %d ws %zu)\n", n_in, out_size, ws_size); grid = -1; return; }
        int dev = 0, cus = 0, per_cu = 0;
        (void)hipGetDevice(&dev); (void)hipDeviceGetAttribute(&cus, hipDeviceAttributeMultiprocessorCount, dev);
        if (hipFuncSetAttribute((const void*)mk_fwd, hipFuncAttributeMaxDynamicSharedMemorySize, LDS_BYTES) != hipSuccess) { fprintf(stderr, "hipFuncSetAttribute failed\n"); grid = -1; return; }
        if (hipOccupancyMaxActiveBlocksPerMultiprocessor(&per_cu, (const void*)mk_fwd, 512, LDS_BYTES) != hipSuccess || per_cu < 1) { fprintf(stderr, "occupancy query says %d\n", per_cu); per_cu = 1; }
        (void)hipGetLastError();
        grid = cus;
    }
    if (grid < 0) return;
    Args a{};
    for (int i = 0; i < 18; ++i) a.in[i] = (const float*)d_in[i];
    a.out = (float*)d_out; a.ws = (unsigned char*)d_ws;
    void* args[] = {&a};
    hipError_t e = hipLaunchCooperativeKernel((const void*)mk_fwd, dim3(grid), dim3(512), args, LDS_BYTES, stream);
    if (e != hipSuccess) fprintf(stderr, "cooperative launch failed: %s (grid %d)\n", hipGetErrorString(e), grid);
}
```
